# Optimizing an MI355X kernel written in HIP

```python
import math
import jax
import jax.numpy as jnp
from jax import lax
import numpy as np

D_MODEL = 2048
BATCH = 16
SEQ = 256
DEPTH = 2
DEC_BATCH = 2
DEC_SEQ = 2048
PAST_LEN = 512

GRID_W = 64
A_HEADS = 6
A_HD = 128
NA_ROWS = 8
NA_COLS = 16
B_HEADS = 5
B_QK = 64
B_HD = 128
C_HEADS = 5
C_DK = 128
C_DV = 128
MLSTM_CHUNK = 64
Q_BLOCK = 128
D_FF = 5504
CONV_W = 3
ROPE_BASE = 10000.0
LN_EPS = 1e-5
RMS_EPS = 1e-6
ALPHA = (2 * DEPTH) ** 0.25
BETA = (8 * DEPTH) ** -0.25
A_W = A_HEADS * A_HD
B_QKW = B_HEADS * 2 * B_QK
B_VW = B_HEADS * B_HD
C_QKW = C_HEADS * C_DK
C_VW = C_HEADS * C_DV
N_GATES = 4 * C_HEADS
IN_SPLITS = (A_W, A_W, A_W, B_QKW, B_QKW, B_VW, C_QKW, C_QKW, C_VW, C_VW, N_GATES)
IN_COLS = sum(IN_SPLITS)

kernel_name = 'hybrid_natten_diffattn_mlstm_dit_step'


def _split_cols(p):
    out, o = [], 0
    for w in IN_SPLITS:
        out.append(p[..., o:o + w])
        o += w
    return out


def _heads(t, n):
    b, s, _ = t.shape
    return t.reshape(b, s, n, -1).transpose(0, 2, 1, 3)


def _merge(t):
    b, h, s, d = t.shape
    return t.transpose(0, 2, 1, 3).reshape(b, s, h * d)


def _layernorm(x, g, b):
    xf = x.astype(jnp.float32)
    mu = xf.mean(-1, keepdims=True)
    var = jnp.square(xf - mu).mean(-1, keepdims=True)
    return (xf - mu) * lax.rsqrt(var + LN_EPS) * g.astype(jnp.float32) + b.astype(jnp.float32)


def _rmsnorm(x, g):
    xf = x.astype(jnp.float32)
    return xf * lax.rsqrt(jnp.mean(xf * xf, -1, keepdims=True) + RMS_EPS) * g.astype(jnp.float32)


def _axial_rope_tables(s, dim):
    t = jnp.arange(s)
    rows = (t // GRID_W).astype(jnp.float32)
    cols = (t % GRID_W).astype(jnp.float32)
    half = dim // 2
    freqs = ROPE_BASE ** (-jnp.arange(0, half, 2, dtype=jnp.float32) / half)
    ar = rows[:, None] * freqs
    ac = cols[:, None] * freqs
    return jnp.cos(ar), jnp.sin(ar), jnp.cos(ac), jnp.sin(ac)


def _rotate_half(x, cos, sin):
    x1, x2 = jnp.split(x, 2, axis=-1)
    return jnp.concatenate([x1 * cos - x2 * sin, x1 * sin + x2 * cos], axis=-1)


def _axial_rope(x, tabs):
    cr, sr, cc, sc = tabs
    xr, xc = jnp.split(x.astype(jnp.float32), 2, axis=-1)
    return jnp.concatenate([_rotate_half(xr, cr, sr), _rotate_half(xc, cc, sc)], axis=-1).astype(x.dtype)


def _blockwise_attention(q1_segs, k1_segs, v, scale, q2_segs=None, k2_segs=None, lam=None):
    bq, h, q_len, _ = q1_segs[0].shape
    nb = q_len // Q_BLOCK
    vf = v.astype(jnp.float32)

    def blocks(t):
        return jnp.moveaxis(t.reshape(bq, h, nb, Q_BLOCK, t.shape[-1]), 2, 0)

    def probs(qblk, ks):
        s = jnp.concatenate([jnp.einsum('bhqd,bhkd->bhqk', q, k) for q, k in zip(qblk, ks)], axis=-1)
        return jax.nn.softmax(s.astype(jnp.float32) * scale, axis=-1)

    q1b = [blocks(q) for q in q1_segs]
    if q2_segs is None:
        def one(qb):
            return jnp.einsum('bhqk,bhkd->bhqd', probs(qb, k1_segs), vf)
        out = lax.map(one, q1b)
    else:
        q2b = [blocks(q) for q in q2_segs]

        def one(qb):
            qa, qc = qb
            p = probs(qa, k1_segs) - lam * probs(qc, k2_segs)
            return jnp.einsum('bhqk,bhkd->bhqd', p, vf)
        out = lax.map(one, (q1b, q2b))
    return jnp.moveaxis(out, 0, 2).reshape(bq, h, q_len, -1)


def _neighbourhood_attention(q, k, v, k_ctx, v_ctx, rpb, scale):
    bq, h, s, dh = q.shape
    n_rows = s // GRID_W
    wr = min(NA_ROWS, n_rows)
    qg = q.reshape(bq, h, n_rows, GRID_W, dh)
    kg = k.reshape(bq, h, n_rows, GRID_W, dh)
    vg = v.reshape(bq, h, n_rows, GRID_W, dh)
    cols = np.arange(GRID_W)
    cs = np.clip(cols - NA_COLS // 2, 0, GRID_W - NA_COLS)
    col_mask = (cols[None, :] >= cs[:, None]) & (cols[None, :] < cs[:, None] + NA_COLS)
    col_idx = np.clip(cols[None, :] - cols[:, None] + NA_COLS - 1, 0, 2 * NA_COLS - 2)
    mask = jnp.asarray(np.tile(col_mask[:, None, :], (1, wr, 1)).reshape(GRID_W, wr * GRID_W))
    n_nb = wr * GRID_W
    vcf = v_ctx.astype(jnp.float32)

    def one(r):
        rs = jnp.clip(r - wr // 2, 0, n_rows - wr)
        kb = lax.dynamic_slice_in_dim(kg, rs, wr, axis=2).reshape(bq, h, n_nb, dh)
        vb = lax.dynamic_slice_in_dim(vg, rs, wr, axis=2).reshape(bq, h, n_nb, dh)
        qr = lax.dynamic_index_in_dim(qg, r, axis=2, keepdims=False)
        row_idx = NA_ROWS - 1 + rs + jnp.arange(wr) - r
        bias = rpb[:, row_idx[:, None, None], col_idx[None]]
        bias = bias.transpose(0, 2, 1, 3).reshape(h, GRID_W, n_nb).astype(jnp.float32)
        s_nb = jnp.einsum('bhqd,bhkd->bhqk', qr, kb).astype(jnp.float32) * scale + bias
        s_nb = jnp.where(mask, s_nb, -jnp.inf)
        s_ctx = jnp.einsum('bhqd,bhkd->bhqk', qr, k_ctx).astype(jnp.float32) * scale
        p = jax.nn.softmax(jnp.concatenate([s_nb, s_ctx], axis=-1), axis=-1)
        return (jnp.einsum('bhqk,bhkd->bhqd', p[..., :n_nb], vb.astype(jnp.float32))
                + jnp.einsum('bhqk,bhkd->bhqd', p[..., n_nb:], vcf))

    out = lax.map(one, jnp.arange(n_rows))
    return jnp.moveaxis(out, 0, 2).reshape(bq, h, s, dh)


def _mlstm_scan(q, k, v, i_pre, logf, c0, n0, m0):
    bq, h, s, _ = q.shape
    nc = s // MLSTM_CHUNK
    tril = jnp.asarray(np.tril(np.ones((MLSTM_CHUNK, MLSTM_CHUNK), dtype=bool)))

    def chunks(t):
        t = t.astype(jnp.float32)
        return jnp.moveaxis(t.reshape((bq, h, nc, MLSTM_CHUNK) + t.shape[3:]), 2, 0)

    def step(carry, xs):
        c_st, n_st, m_st = carry
        qc, kc, vc, ic, fc = xs
        b = jnp.cumsum(fc, axis=-1)
        d = jnp.where(tril, b[..., :, None] - b[..., None, :] + ic[..., None, :], -jnp.inf)
        inter = b + m_st[..., None]
        m_row = jnp.maximum(d.max(-1), inter)
        w_intra = jnp.exp(d - m_row[..., None])
        w_state = jnp.exp(inter - m_row)
        sc = jnp.einsum('bhtd,bhsd->bhts', qc, kc) * w_intra
        num = w_state[..., None] * jnp.einsum('bhtd,bhde->bhte', qc, c_st) + jnp.einsum('bhts,bhse->bhte', sc, vc)
        den = w_state * jnp.einsum('bhtd,bhd->bht', qc, n_st) + sc.sum(-1)
        h_out = num / jnp.maximum(jnp.abs(den), jnp.exp(-m_row))[..., None]
        b_last = b[..., -1]
        g = b_last[..., None] - b + ic
        m_new = jnp.maximum(b_last + m_st, g.max(-1))
        w_old = jnp.exp(b_last + m_st - m_new)
        w_s = jnp.exp(g - m_new[..., None])
        c_new = w_old[..., None, None] * c_st + jnp.einsum('bhs,bhsd,bhse->bhde', w_s, kc, vc)
        n_new = w_old[..., None] * n_st + jnp.einsum('bhs,bhsd->bhd', w_s, kc)
        return (c_new, n_new, m_new), h_out

    xs = tuple(chunks(t) for t in (q, k, v, i_pre, logf))
    init = (c0.astype(jnp.float32), n0.astype(jnp.float32), m0.astype(jnp.float32))
    (c_f, n_f, m_f), hs = lax.scan(step, init, xs)
    return jnp.moveaxis(hs, 0, 2).reshape(bq, h, s, -1), c_f, n_f, m_f


def _mlstm_bidir(q, k, v, gates, c0, n0, m0):
    def flip(t):
        return jnp.flip(t, axis=2)
    i_f, f_f = gates[0], jax.nn.log_sigmoid(gates[1])
    i_b, f_b = gates[2], jax.nn.log_sigmoid(gates[3])
    hf, cf, nf, mf = _mlstm_scan(q, k, v, i_f, f_f, c0[:, 0], n0[:, 0], m0[:, 0])
    hb, cb, nb, mb = _mlstm_scan(flip(q), flip(k), flip(v), flip(i_b), flip(f_b), c0[:, 1], n0[:, 1], m0[:, 1])
    return hf + flip(hb), jnp.stack([cf, cb], 1), jnp.stack([nf, nb], 1), jnp.stack([mf, mb], 1)


def _diff_lambda(b_lambda, lam_init):
    lf = b_lambda.astype(jnp.float32)
    return jnp.exp(jnp.sum(lf[0] * lf[1])) - jnp.exp(jnp.sum(lf[2] * lf[3])) + lam_init


def _mixer(h, w_in, c_gate_b, a_rpb, b_lambda, b_subln, c_norm, w_out, lam_init, ctx=None):
    bq, s, _ = h.shape
    qa, ka, va, qb, kb, vb, qc, kc, vc, oc, gc = _split_cols(h @ w_in)
    qa, ka, va = _heads(qa, A_HEADS), _heads(ka, A_HEADS), _heads(va, A_HEADS)
    qb, kb, vb = _heads(qb, B_HEADS), _heads(kb, B_HEADS), _heads(vb, B_HEADS)
    qc, kc, vc = (_heads(t, C_HEADS).astype(jnp.float32) for t in (qc, kc, vc))
    gates = (gc.reshape(bq, s, 4, C_HEADS).astype(jnp.float32) + c_gate_b.astype(jnp.float32)).transpose(2, 0, 3, 1)
    q1, q2 = jnp.split(qb, 2, axis=-1)
    k1, k2 = jnp.split(kb, 2, axis=-1)
    lam = _diff_lambda(b_lambda, lam_init)
    a_scale = A_HD ** -0.5
    b_scale = B_QK ** -0.5
    if ctx is None:
        ya = _blockwise_attention([qa], [ka], va, a_scale)
        yb = _blockwise_attention([q1], [k1], vb, b_scale, [q2], [k2], lam)
        c0 = jnp.zeros((bq, 2, C_HEADS, C_DK, C_DV), jnp.float32)
        n0 = jnp.zeros((bq, 2, C_HEADS, C_DK), jnp.float32)
        m0 = jnp.zeros((bq, 2, C_HEADS), jnp.float32)
    else:
        a_k, a_v, b_k, b_v, c0, n0, m0 = ctx
        ya = _neighbourhood_attention(qa, ka, va, a_k, a_v, a_rpb, a_scale)
        tabs = _axial_rope_tables(s, B_QK)
        bk1, bk2 = jnp.split(b_k, 2, axis=-1)
        v_all = jnp.concatenate([vb, b_v.astype(vb.dtype)], axis=2)
        yb = _blockwise_attention([_axial_rope(q1, tabs), q1], [_axial_rope(k1, tabs), bk1], v_all, b_scale,
                                  [_axial_rope(q2, tabs), q2], [_axial_rope(k2, tabs), bk2], lam)
    hc, c_fin, n_fin, m_fin = _mlstm_bidir(qc * C_DK ** -0.5, kc, vc, gates, c0, n0, m0)
    yb = _rmsnorm(yb, b_subln) * (1.0 - lam_init)
    yc = jax.nn.sigmoid(oc.astype(jnp.float32)) * _merge(_rmsnorm(hc, c_norm))
    y = jnp.concatenate([_merge(ya), _merge(yb), yc], axis=-1).astype(h.dtype) @ w_out
    if ctx is None:
        return y, (ka, va, kb, vb, c_fin, n_fin, m_fin)
    return y, None


def _conv_ffn(h, w_up, conv_w, conv_b, w_down):
    s = h.shape[1]
    u = h @ w_up
    pad = CONV_W // 2
    up = jnp.pad(u, ((0, 0), (pad, pad), (0, 0)))
    u = sum(up[:, j:j + s] * conv_w[j] for j in range(CONV_W)) + conv_b
    a, g = jnp.split(u, 2, axis=-1)
    return (jax.nn.silu(g) * a) @ w_down


def _block(x, cond, lp, lam_init, ctx=None):
    (w_mod, b_mod, w_in, c_gate_b, a_rpb, b_lambda, b_subln, c_norm, w_out,
     ln1_g, ln1_b, ln2_g, ln2_b, w_up, conv_w, conv_b, w_down) = lp
    mods = jax.nn.silu(cond.astype(jnp.float32)) @ w_mod + b_mod
    sh_a, sc_a, g_a, sh_f, sc_f, g_f = [m[:, None, :].astype(x.dtype) for m in jnp.split(mods, 6, axis=-1)]
    y, new_ctx = _mixer(x * (1 + sc_a) + sh_a, w_in, c_gate_b, a_rpb, b_lambda, b_subln, c_norm, w_out,
                        lam_init, ctx)
    x = _layernorm(ALPHA * x + g_a * y, ln1_g, ln1_b).astype(x.dtype)
    f = _conv_ffn(x * (1 + sc_f) + sh_f, w_up, conv_w, conv_b, w_down)
    x = _layernorm(ALPHA * x + g_f * f, ln2_g, ln2_b).astype(x.dtype)
    return x, new_ctx


def setup_inputs(seed: int = 0) -> dict:
    key = jax.random.key(seed)
    ks = jax.random.split(key, 32)

    def nrm(k, shape, s):
        return jax.random.normal(k, shape, jnp.float32) * s

    f_bias = jnp.linspace(3.0, 6.0, C_HEADS)
    gate_base = jnp.array([0.0, 1.0, 0.0, 1.0], jnp.float32)[:, None] * f_bias[None, :]
    return {
        'x_prompt': nrm(ks[0], (BATCH, SEQ, D_MODEL), 1.0),
        'x_sample': nrm(ks[1], (DEC_BATCH, DEC_SEQ, D_MODEL), 1.0),
        'cache_a_k': nrm(ks[2], (DEC_BATCH, DEPTH, A_HEADS, PAST_LEN, A_HD), 1.0),
        'cache_a_v': nrm(ks[3], (DEC_BATCH, DEPTH, A_HEADS, PAST_LEN, A_HD), 1.0),
        'cache_b_k': nrm(ks[4], (DEC_BATCH, DEPTH, B_HEADS, PAST_LEN, 2 * B_QK), 1.0),
        'cache_b_v': nrm(ks[5], (DEC_BATCH, DEPTH, B_HEADS, PAST_LEN, B_HD), 1.0),
        'state_c_C': nrm(ks[6], (DEC_BATCH, DEPTH, 2, C_HEADS, C_DK, C_DV), 1.0),
        'state_c_n': nrm(ks[7], (DEC_BATCH, DEPTH, 2, C_HEADS, C_DK), 1.0),
        'state_c_m': nrm(ks[8], (DEC_BATCH, DEPTH, 2, C_HEADS), 1.0),
        'c': nrm(ks[9], (DEC_BATCH, D_MODEL), 1.0),
        'c_ctx': nrm(ks[10], (D_MODEL,), 1.0),
        'w_mod': nrm(ks[11], (DEPTH, D_MODEL, 6 * D_MODEL), 0.5 * D_MODEL ** -0.5),
        'b_mod': nrm(ks[12], (DEPTH, 6 * D_MODEL), 0.02),
        'w_in': nrm(ks[13], (DEPTH, D_MODEL, IN_COLS), D_MODEL ** -0.5),
        'c_gate_b': nrm(ks[14], (DEPTH, 4, C_HEADS), 0.1) + gate_base,
        'a_rpb': nrm(ks[15], (DEPTH, A_HEADS, 2 * NA_ROWS - 1, 2 * NA_COLS - 1), 0.1),
        'b_lambda': nrm(ks[16], (DEPTH, 4, B_QK), 0.1),
        'b_subln': 1.0 + nrm(ks[17], (DEPTH, B_HD), 0.02),
        'c_norm': 1.0 + nrm(ks[18], (DEPTH, C_DV), 0.02),
        'w_out': nrm(ks[19], (DEPTH, D_MODEL, D_MODEL), BETA * D_MODEL ** -0.5),
        'ln1_g': 1.0 + nrm(ks[20], (DEPTH, D_MODEL), 0.02),
        'ln1_b': nrm(ks[21], (DEPTH, D_MODEL), 0.02),
        'ln2_g': 1.0 + nrm(ks[22], (DEPTH, D_MODEL), 0.02),
        'ln2_b': nrm(ks[23], (DEPTH, D_MODEL), 0.02),
        'w_up': nrm(ks[24], (DEPTH, D_MODEL, 2 * D_FF), D_MODEL ** -0.5),
        'conv_w': nrm(ks[25], (DEPTH, CONV_W, 2 * D_FF), CONV_W ** -0.5),
        'conv_b': nrm(ks[26], (DEPTH, 2 * D_FF), 0.02),
        'w_down': nrm(ks[27], (DEPTH, D_FF, D_MODEL), BETA * D_FF ** -0.5),
    }


def reference(x_prompt, x_sample, cache_a_k, cache_a_v, cache_b_k, cache_b_v, state_c_C, state_c_n, state_c_m,
              c, c_ctx, w_mod, b_mod, w_in, c_gate_b, a_rpb, b_lambda, b_subln, c_norm, w_out,
              ln1_g, ln1_b, ln2_g, ln2_b, w_up, conv_w, conv_b, w_down):
    xp = x_prompt
    xs = x_sample
    ctx_out = []
    for l in range(DEPTH):
        lam_init = 0.8 - 0.6 * math.exp(-0.3 * l)
        lp = (w_mod[l], b_mod[l], w_in[l], c_gate_b[l], a_rpb[l], b_lambda[l], b_subln[l], c_norm[l], w_out[l],
              ln1_g[l], ln1_b[l], ln2_g[l], ln2_b[l], w_up[l], conv_w[l], conv_b[l], w_down[l])
        xp, new_ctx = _block(xp, c_ctx[None, :], lp, lam_init)
        ctx_out.append(new_ctx)
        cached = (cache_a_k[:, l], cache_a_v[:, l], cache_b_k[:, l], cache_b_v[:, l],
                  state_c_C[:, l], state_c_n[:, l], state_c_m[:, l])
        xs, _ = _block(xs, c, lp, lam_init, cached)
    new_a_k = jnp.stack([t[0] for t in ctx_out], axis=1)
    new_a_v = jnp.stack([t[1] for t in ctx_out], axis=1)
    new_b_k = jnp.stack([t[2] for t in ctx_out], axis=1)
    new_b_v = jnp.stack([t[3] for t in ctx_out], axis=1)
    new_c_C = jnp.stack([t[4] for t in ctx_out], axis=1)
    new_c_n = jnp.stack([t[5] for t in ctx_out], axis=1)
    new_c_m = jnp.stack([t[6] for t in ctx_out], axis=1)
    return (xp, xs, new_a_k, new_a_v, new_b_k, new_b_v, new_c_C, new_c_n, new_c_m)
```

```cpp
#include <hip/hip_runtime.h>
#include <hip/hip_cooperative_groups.h>
#include <cstdio>
namespace cg = cooperative_groups;

#define DEVI __device__ __forceinline__
typedef unsigned short bf16_t;
typedef short bf16x8 __attribute__((ext_vector_type(8)));
typedef float f32x4 __attribute__((ext_vector_type(4)));
typedef unsigned u32x4 __attribute__((ext_vector_type(4)));
typedef unsigned u32x2 __attribute__((ext_vector_type(2)));

constexpr int D = 2048, T = 8192, TC = 4096, NIN = 6804, NINP = 6912, DFF = 5504, NUP = 11008;
constexpr float ALPHA = 1.4142135623730951f;
constexpr float LOG2E = 1.4426950408889634f;

constexpr size_t O_Y = 0, O_AK = 16777216, O_AV = 23068672, O_BK = 29360128, O_BV = 34603008, O_CC = 39845888, O_CN = 45088768, O_CM = 45129728;

constexpr size_t al256(size_t x) { return (x + 255) & ~(size_t)255; }
constexpr size_t W_CNT = 0;
constexpr size_t W_WIN = 4096;
constexpr size_t W_WOUT = W_WIN + (size_t)2 * NINP * D * 2;
constexpr size_t W_WUP = W_WOUT + (size_t)2 * D * D * 2;
constexpr size_t W_WDN = W_WUP + (size_t)2 * NUP * D * 2;
constexpr size_t W_MODP = W_WDN + (size_t)2 * D * DFF * 2;
constexpr size_t W_MODS = W_MODP + (size_t)2 * 16 * 3 * 12288 * 4;
constexpr size_t W_ROPE = W_MODS + (size_t)2 * 3 * 12288 * 4;
constexpr size_t W_CKA = W_ROPE + 8192;
constexpr size_t W_CVA = W_CKA + (size_t)24 * 65536 * 2;
constexpr size_t W_CKB = W_CVA + (size_t)24 * 65536 * 2;
constexpr size_t W_CVB = W_CKB + (size_t)20 * 65536 * 2;
constexpr size_t W_X = W_CVB + (size_t)20 * 65536 * 2;
constexpr size_t W_H = W_X + (size_t)T * D * 4;
constexpr size_t W_R = W_H + (size_t)T * D * 2;
constexpr size_t SZA = (size_t)T * 768 * 2, SZB = (size_t)T * 640 * 2;
constexpr size_t W_QA = W_R, W_KA = W_QA + SZA, W_VAT = W_KA + SZA;
constexpr size_t W_QB = W_VAT + SZA, W_QBR = W_QB + SZB, W_KB = W_QBR + SZB / 2, W_VBT = W_KB + SZB;
constexpr size_t W_QC = W_VBT + SZB, W_KC = W_QC + SZB, W_KCT = W_KC + SZB, W_VCT = W_KCT + SZB, W_OG = W_VCT + SZB;
constexpr size_t W_G = W_OG + SZB;
constexpr size_t W_Y = W_G + (size_t)T * 20 * 4;
constexpr size_t W_ST = W_Y + (size_t)T * D * 2;
constexpr size_t W_SN = W_ST + (size_t)1920 * 16384 * 4;
constexpr size_t W_SS = W_SN + (size_t)1920 * 128 * 4;
constexpr size_t W_REND = W_SS + (size_t)3 * 1920 * 4;
constexpr size_t W_U = W_R;
constexpr size_t W_UEND = W_U + (size_t)T * NUP * 2;
constexpr size_t W_ACT = al256(W_REND > W_UEND ? W_REND : W_UEND);
constexpr size_t W_END = W_ACT + (size_t)T * DFF * 2;

struct P {
    const float* in[28];
    float* out;
    char* ws;
    int ph_lo, ph_hi;
};
enum { I_XP = 0, I_XS, I_CAK, I_CAV, I_CBK, I_CBV, I_SC, I_SN, I_SM, I_C, I_CCTX, I_WMOD, I_BMOD, I_WIN, I_GATEB, I_RPB, I_LAMBDA, I_SUBLN, I_CNORM, I_WOUT,
       I_LN1G, I_LN1B, I_LN2G, I_LN2B, I_WUP, I_CONVW, I_CONVB, I_WDN };

DEVI float bf2f(bf16_t v) { return __uint_as_float(((unsigned)v) << 16); }
DEVI float bflo(unsigned u) { return __uint_as_float(u << 16); }
DEVI float bfhi(unsigned u) { return __uint_as_float(u & 0xffff0000u); }
DEVI float wave_sum(float v) {
#pragma unroll
    for (int o = 32; o > 0; o >>= 1) v += __shfl_xor(v, o);
    return v;
}
DEVI float wave_max(float v) {
#pragma unroll
    for (int o = 32; o > 0; o >>= 1) v = fmaxf(v, __shfl_xor(v, o));
    return v;
}
DEVI float sigmoidf_(float x) { return 1.0f / (1.0f + __expf(-x)); }
DEVI float siluf_(float x) { return x / (1.0f + __expf(-x)); }
#define ONE_LAUNCH 0
namespace pg8 {
#define PG8_LAS __attribute__((address_space(3)))
typedef unsigned short bf16_t;
typedef short bf16x8 __attribute__((ext_vector_type(8)));
typedef float f32x4 __attribute__((ext_vector_type(4)));
typedef unsigned u32x4 __attribute__((ext_vector_type(4)));
constexpr int BM = 256, BK = 64, HALF = 128, HTB = HALF * BK * 2  , STAGE_BYTES = 8 * HTB, NXCD = 8, WGM = 8;

__host__ __device__ __forceinline__ int lds_byte(int r, int c) { const int st = (r >> 4) * 2 + (c >> 5), rr = r & 15, cc = c & 31, ob = rr * 64 + cc * 2; return st * 1024 + (ob ^ (((ob >> 9) & 1) << 5)); }
__host__ __device__ __forceinline__ void stage_rc(int b, int& R, int& C) { const int st = b / 1024, sb = b % 1024, swz = sb ^ (((sb >> 9) & 1) << 5); R = (st >> 1) * 16 + swz / 64; C = (st & 1) * 32 + (swz % 64) / 2; }
__host__ __device__ __forceinline__ int perm32(int rho) { const int n = rho >> 4, i = rho & 15; return 8 * (i >> 2) + 4 * n + (i & 3); }

struct Unit { int pm, pn; };
struct Gemm { const bf16_t* A; const bf16_t* Bt; int M, N, K; };

struct StaticOrder {
    int nM, nN, nwg, G, c;
    __host__ __device__ void init(int M, int N, int G_, int c_) { nM = M / BM; nN = N / BM; nwg = nM * nN; G = G_; c = c_; }
    __host__ __device__ bool next(int i, Unit& u) const {
        const long L = (long)i * G + c; if (L >= nwg) return false;
        int wgid = (int)L; { const int q = nwg / NXCD, r = nwg % NXCD, xcd = wgid % NXCD, off = wgid / NXCD; wgid = (xcd < r ? xcd * (q + 1) : r * (q + 1) + (xcd - r) * q) + off; }
        const int nig = WGM * nN, gid = wgid / nig, fm = gid * WGM, gsz = (nM - fm) < WGM ? (nM - fm) : WGM;
        u.pm = fm + ((wgid % nig) % gsz); u.pn = (wgid % nig) / gsz; return true;
    }
    __device__ __forceinline__ void a_ready(const Unit&) const {}
    __device__ __forceinline__ void done(const Unit&) const {}
};
__device__ __forceinline__ unsigned cvt_pk_bf16(float lo, float hi) { unsigned r; asm volatile("v_cvt_pk_bf16_f32 %0, %1, %2" : "=v"(r) : "v"(lo), "v"(hi)); return r; }
template <class Epi, class Sched>
__device__ __forceinline__ void gemm_phase(PG8_LAS unsigned char* lds, const Gemm g, const Sched& S, const Epi& E) {
    const int tid = threadIdx.x, wid = __builtin_amdgcn_readfirstlane(tid >> 6), lane = tid & 63, wr = wid >> 2, wc = wid & 3, fr = lane & 15, fq = lane >> 4;
    const int K = g.K, nt = K / BK;
    unsigned voffA[2], voffB[2];
#pragma unroll
    for (int i = 0; i < 2; ++i) { int R, C; stage_rc(tid * 16 + i * 8192, R, C); const int Rb = Epi::PERM ? ((R & ~31) + perm32(R & 31)) : R;
        voffA[i] = (unsigned)(R * K + C) * 2u; voffB[i] = (unsigned)(Rb * K + C) * 2u; }
    const size_t kstep = (size_t)(BK * 2);
    const size_t hstep = (size_t)HALF * K * 2;
    const size_t tstep = 2 * hstep;
    const unsigned ldsw = (unsigned)wid * 1024u;
    const int aoff = lds_byte(wr * 64 + fr, fq * 8), boff = lds_byte(wc * 32 + fr, fq * 8);
#define PG8_SA(b, h) (((b) * 2 + (h)) * HTB)
#define PG8_SB(b, h) ((4 + (b) * 2 + (h)) * HTB)
#define PG8_STAGE(bufoff, gbase, voff) do { _Pragma("unroll") for (int _i = 0; _i < 2; ++_i) \
        __builtin_amdgcn_global_load_lds((const unsigned*)((const char*)(gbase) + (voff)[_i]), (PG8_LAS unsigned*)(lds + (bufoff) + ldsw + _i * 8192), 16, 0, 0); } while (0)
#define PG8_LDA(dst, b, h) do { _Pragma("unroll") for (int m = 0; m < 4; ++m) _Pragma("unroll") for (int k = 0; k < 2; ++k) dst[m][k] = *(const PG8_LAS bf16x8*)(lds + PG8_SA(b, h) + aoff + m * 2048 + k * 1024); } while (0)
#define PG8_LDB(dst, b, h) do { _Pragma("unroll") for (int n = 0; n < 2; ++n) _Pragma("unroll") for (int k = 0; k < 2; ++k) dst[n][k] = *(const PG8_LAS bf16x8*)(lds + PG8_SB(b, h) + boff + n * 2048 + k * 1024); } while (0)
#define PG8_MMA(ai, bj, At, Bt) do { __builtin_amdgcn_s_setprio(1); _Pragma("unroll") for (int m = 0; m < 4; ++m) _Pragma("unroll") for (int n = 0; n < 2; ++n) _Pragma("unroll") for (int k = 0; k < 2; ++k) \
        acc[ai][bj][m][n] = __builtin_amdgcn_mfma_f32_16x16x32_bf16(Bt[n][k], At[m][k], acc[ai][bj][m][n], 0, 0, 0); __builtin_amdgcn_s_setprio(0); } while (0)
#define PG8_WAIT_V(n) asm volatile("s_waitcnt vmcnt(" #n ")" ::: "memory")
#define PG8_WAIT_L(n) asm volatile("s_waitcnt lgkmcnt(" #n ")" ::: "memory")
#define PG8_BAR __builtin_amdgcn_s_barrier()
#define PG8_SCHED __builtin_amdgcn_sched_barrier(0)
    Unit cur, nxt; int ui = 0;
    if (!S.next(0, cur)) return;
    f32x4 acc[2][2][4][2];
#pragma unroll
    for (int a = 0; a < 2; ++a)
#pragma unroll
        for (int b = 0; b < 2; ++b)
#pragma unroll
            for (int m = 0; m < 4; ++m)
#pragma unroll
                for (int n = 0; n < 2; ++n) acc[a][b][m][n] = (f32x4){0.f, 0.f, 0.f, 0.f};
    bf16x8 At[4][2], B0[2][2], B1[2][2];
    const char* cA = (const char*)g.A + (size_t)cur.pm * tstep; const char* cB = (const char*)g.Bt + (size_t)cur.pn * tstep;
    S.a_ready(cur);
    PG8_STAGE(PG8_SB(0, 0), cB, voffB); PG8_STAGE(PG8_SA(0, 0), cA, voffA); PG8_STAGE(PG8_SB(0, 1), cB + hstep, voffB); PG8_STAGE(PG8_SA(0, 1), cA + hstep, voffA);
    if (wr == 1) PG8_BAR;
    PG8_WAIT_V(4); PG8_BAR;
    PG8_STAGE(PG8_SB(1, 0), cB + kstep, voffB); PG8_STAGE(PG8_SA(1, 0), cA + kstep, voffA); PG8_STAGE(PG8_SB(1, 1), cB + hstep + kstep, voffB);
    PG8_WAIT_V(6); PG8_BAR;
    for (;;) {
        const bool has_next = S.next(ui + 1, nxt);
        const char* nA = has_next ? (const char*)g.A + (size_t)nxt.pm * tstep : cA; const char* nB = has_next ? (const char*)g.Bt + (size_t)nxt.pn * tstep : cB;
        for (int t = 0; t < nt; t += 2) {
            const bool last = (t == nt - 2);
            const char* a1 = cA + (size_t)(t + 1) * kstep;
            const char* a2 = last ? nA : cA + (size_t)(t + 2) * kstep; const char* b2 = last ? nB : cB + (size_t)(t + 2) * kstep;
            const char* a3 = a2 + kstep; const char* b3 = b2 + kstep;
            if (last && has_next) S.a_ready(nxt);
            PG8_LDB(B0, 0, 0); PG8_SCHED; PG8_LDA(At, 0, 0); PG8_STAGE(PG8_SA(1, 1), a1 + hstep, voffA);
            PG8_WAIT_L(8); PG8_BAR; PG8_WAIT_L(0); PG8_MMA(0, 0, At, B0); PG8_BAR; PG8_SCHED;
            PG8_LDB(B1, 0, 1); PG8_STAGE(PG8_SB(0, 0), b2, voffB);
            PG8_BAR; PG8_WAIT_L(0); PG8_MMA(0, 1, At, B1); PG8_BAR;
            PG8_LDA(At, 0, 1); PG8_STAGE(PG8_SA(0, 0), a2, voffA);
            PG8_BAR; PG8_WAIT_L(0); PG8_MMA(1, 0, At, B0); PG8_BAR; PG8_SCHED;
            PG8_STAGE(PG8_SB(0, 1), b2 + hstep, voffB);
            PG8_WAIT_V(6); PG8_BAR; PG8_MMA(1, 1, At, B1); PG8_BAR;
            PG8_LDB(B0, 1, 0); PG8_SCHED; PG8_LDA(At, 1, 0); PG8_STAGE(PG8_SA(0, 1), a2 + hstep, voffA);
            PG8_WAIT_L(8); PG8_BAR; PG8_WAIT_L(0); PG8_MMA(0, 0, At, B0); PG8_BAR; PG8_SCHED;
            PG8_LDB(B1, 1, 1); PG8_STAGE(PG8_SB(1, 0), b3, voffB);
            PG8_BAR; PG8_WAIT_L(0); PG8_MMA(0, 1, At, B1); PG8_BAR;
            PG8_LDA(At, 1, 1); PG8_STAGE(PG8_SA(1, 0), a3, voffA);
            PG8_BAR; PG8_WAIT_L(0); PG8_MMA(1, 0, At, B0); PG8_BAR; PG8_SCHED;
            PG8_STAGE(PG8_SB(1, 1), b3 + hstep, voffB);
            PG8_WAIT_V(6); PG8_BAR; PG8_MMA(1, 1, At, B1); PG8_BAR;
        }
        if constexpr (!Epi::AFTER_DRAIN) { E(acc, cur, wr, wc, fr, fq); S.done(cur); }
        if (!has_next) break;
#pragma unroll
        for (int a = 0; a < 2; ++a)
#pragma unroll
            for (int b = 0; b < 2; ++b)
#pragma unroll
                for (int m = 0; m < 4; ++m)
#pragma unroll
                    for (int n = 0; n < 2; ++n) acc[a][b][m][n] = (f32x4){0.f, 0.f, 0.f, 0.f};
        cur = nxt; cA = nA; cB = nB; ++ui;
    }
    PG8_WAIT_V(0);
    if (wr == 0) PG8_BAR;
    PG8_BAR;
    if constexpr (Epi::AFTER_DRAIN) { E.fused(acc, cur, wr, wc, fr, fq, lds, wid, lane); S.done(cur); }
#undef PG8_SA
#undef PG8_SB
#undef PG8_STAGE
#undef PG8_LDA
#undef PG8_LDB
#undef PG8_MMA
#undef PG8_WAIT_V
#undef PG8_WAIT_L
#undef PG8_BAR
#undef PG8_SCHED
}
}

using pg8::cvt_pk_bf16;
DEVI bf16x8 ld8(const bf16_t* p) { return *(const bf16x8*)p; }
DEVI bf16x8 ld4x2(const bf16_t* p0, const bf16_t* p1) {
    const u32x2 a = *(const u32x2*)p0, b = *(const u32x2*)p1;
    const u32x4 r = {a[0], a[1], b[0], b[1]};
    return __builtin_bit_cast(bf16x8, r);
}
DEVI bf16x8 pack8(f32x4 a, f32x4 b) {
    const u32x4 r = {cvt_pk_bf16(a[0], a[1]), cvt_pk_bf16(a[2], a[3]), cvt_pk_bf16(b[0], b[1]), cvt_pk_bf16(b[2], b[3])};
    return __builtin_bit_cast(bf16x8, r);
}
DEVI void st4(bf16_t* p, f32x4 v) { const u32x2 r = {cvt_pk_bf16(v[0], v[1]), cvt_pk_bf16(v[2], v[3])}; *(u32x2*)p = r; }
DEVI bf16_t f2bf1(float f) { return (bf16_t)(cvt_pk_bf16(f, 0.f) & 0xffffu); }
DEVI f32x4 mfma16(bf16x8 a, bf16x8 b, f32x4 c) { return __builtin_amdgcn_mfma_f32_16x16x32_bf16(a, b, c, 0, 0, 0); }
DEVI float ex2(float x) { return __builtin_amdgcn_exp2f(x); }
DEVI int clampi(int v, int lo, int hi) { return v < lo ? lo : (v > hi ? hi : v); }
DEVI int cond_of_row(int t) { return t < TC ? 0 : 1 + ((t - TC) >> 11); }

DEVI void transpose_tile(const float* __restrict__ W, bf16_t* __restrict__ Wt, int K, int N, int tk, int tn, float* sm) {
    const int tid = threadIdx.x;
#pragma unroll
    for (int p = 0; p < 2; ++p) {
        const int kr = p * 32 + (tid >> 4), nc = (tid & 15) * 4;
        const int gk = tk * 64 + kr, gn = tn * 64 + nc;
        f32x4 v = {0.f, 0.f, 0.f, 0.f};
        if (gn < N) v = *(const f32x4*)(W + (size_t)gk * N + gn);
        sm[kr * 65 + nc + 0] = v[0]; sm[kr * 65 + nc + 1] = v[1]; sm[kr * 65 + nc + 2] = v[2]; sm[kr * 65 + nc + 3] = v[3];
    }
    __syncthreads();
    const int n = tid >> 3, kg = tid & 7;
    float f[8];
#pragma unroll
    for (int j = 0; j < 8; ++j) f[j] = sm[(kg * 8 + j) * 65 + n];
    const u32x4 o = {cvt_pk_bf16(f[0], f[1]), cvt_pk_bf16(f[2], f[3]), cvt_pk_bf16(f[4], f[5]), cvt_pk_bf16(f[6], f[7])};
    *(u32x4*)(Wt + (size_t)(tn * 64 + n) * K + tk * 64 + kg * 8) = o;
    __syncthreads();
}
DEVI void conv_T(const float* W, bf16_t* Wt, int K, int N, int Npad, int nmat, int rot, float* sm) {
    const int tkn = K / 64, tnn = Npad / 64, per = tkn * tnn, total = per * nmat;
    const int start = (int)((blockIdx.x + gridDim.x - (rot % gridDim.x)) % gridDim.x);
    for (int t = start; t < total; t += gridDim.x) {
        const int mat = t / per, r = t % per, tk = r / tnn, tn = r % tnn;
        transpose_tile(W + (size_t)mat * K * N, Wt + (size_t)mat * Npad * K, K, N, tk, tn, sm);
    }
}
DEVI void conv_plain(const float* src, bf16_t* dst, size_t n4) {
    for (size_t i = (size_t)blockIdx.x * blockDim.x + threadIdx.x; i < n4; i += (size_t)gridDim.x * blockDim.x) st4(dst + i * 4, *(const f32x4*)(src + i * 4));
}
DEVI void phase0a(const P& p, float* sm) {
    const int tid = threadIdx.x;
    char* ws = p.ws;
    for (int it = blockIdx.x; it < 192; it += gridDim.x) {
        const int l = it / 96, jb = (it % 96) / 16, kc = it % 16;
        if (tid < 384) { const int ci = tid >> 7, k = kc * 128 + (tid & 127); const float cv = ci == 0 ? p.in[I_CCTX][k] : p.in[I_C][(ci - 1) * D + k]; sm[tid] = siluf_(cv); }
        __syncthreads();
        const int j = jb * 2048 + tid * 4;
        f32x4 a0 = {0.f, 0.f, 0.f, 0.f}, a1 = a0, a2 = a0;
        const float* wp = p.in[I_WMOD] + ((size_t)l * D + kc * 128) * 12288 + j;
#pragma unroll 8
        for (int kk = 0; kk < 128; ++kk) {
            const f32x4 w = __builtin_nontemporal_load((const f32x4*)(wp + (size_t)kk * 12288));
            a0 += sm[kk] * w; a1 += sm[128 + kk] * w; a2 += sm[256 + kk] * w;
        }
        float* mp = (float*)(ws + W_MODP) + ((size_t)(l * 16 + kc) * 3) * 12288 + j;
        *(f32x4*)(mp) = a0; *(f32x4*)(mp + 12288) = a1; *(f32x4*)(mp + 2 * 12288) = a2;
        __syncthreads();
    }
    if (blockIdx.x == gridDim.x - 1) {
        float* rt = (float*)(ws + W_ROPE);
        for (int i = tid; i < 1024; i += 512) {
            const int pos = i >> 4, fi = i & 15;
            const double freq = exp(-(double)fi * (9.210340371976184 / 16.0));
            const double ang = (double)pos * freq;
            rt[i] = (float)cos(ang); rt[1024 + i] = (float)sin(ang);
        }
    }
    for (int l = 0; l < 2; ++l) {
        conv_T(p.in[I_WIN] + (size_t)l * D * NIN, (bf16_t*)(ws + W_WIN) + (size_t)l * NINP * D, D, NIN, NINP, 1, 192 + l * 7, sm);
        conv_T(p.in[I_WOUT] + (size_t)l * D * D, (bf16_t*)(ws + W_WOUT) + (size_t)l * D * D, D, D, D, 1, 64 + l * 11, sm);
        conv_T(p.in[I_WUP] + (size_t)l * D * NUP, (bf16_t*)(ws + W_WUP) + (size_t)l * NUP * D, D, NUP, NUP, 1, 128 + l * 13, sm);
        conv_T(p.in[I_WDN] + (size_t)l * DFF * D, (bf16_t*)(ws + W_WDN) + (size_t)l * D * DFF, DFF, D, D, 1, 32 + l * 17, sm);
    }
    conv_T(p.in[I_CAV], (bf16_t*)(ws + W_CVA), 512, 128, 128, 24, 100, sm);
    conv_T(p.in[I_CBV], (bf16_t*)(ws + W_CVB), 512, 128, 128, 20, 200, sm);
    conv_plain(p.in[I_CAK], (bf16_t*)(ws + W_CKA), (size_t)24 * 65536 / 4);
    conv_plain(p.in[I_CBK], (bf16_t*)(ws + W_CKB), (size_t)20 * 65536 / 4);
}
DEVI void phase0b(const P& p) {
    const float* mp = (const float*)(p.ws + W_MODP);
    float* mo = (float*)(p.ws + W_MODS);
    for (int i = blockIdx.x * blockDim.x + threadIdx.x; i < 2 * 3 * 12288; i += gridDim.x * blockDim.x) {
        const int l = i / 36864, r = i % 36864, ci = r / 12288, j = r % 12288;
        float s = p.in[I_BMOD][l * 12288 + j];
        for (int kc = 0; kc < 16; ++kc) s += mp[((size_t)(l * 16 + kc) * 3 + ci) * 12288 + j];
        mo[i] = s;
    }
}
DEVI void phase0c(const P& p) {
    const float* mods = (const float*)(p.ws + W_MODS);
    bf16_t* H = (bf16_t*)(p.ws + W_H);
    for (int i = blockIdx.x * blockDim.x + threadIdx.x; i < T * 512; i += gridDim.x * blockDim.x) {
        const int t = i >> 9, c = (i & 511) * 4;
        const float* xr = t < TC ? p.in[I_XP] + (size_t)t * D : p.in[I_XS] + (size_t)(t - TC) * D;
        const float* mr = mods + (size_t)cond_of_row(t) * 12288;
        const f32x4 x = *(const f32x4*)(xr + c), sh = *(const f32x4*)(mr + c), sc = *(const f32x4*)(mr + 2048 + c);
        st4(H + (size_t)t * D + c, x * (1.0f + sc) + sh);
    }
}

struct EpiIn {
    static constexpr bool PERM = false, AFTER_DRAIN = false;
    char* ws; float* out; const float* gate_b; int l;
    DEVI void operator()(const f32x4 (&acc)[2][2][4][2], const pg8::Unit& u, int wr, int wc, int fr, int fq) const {
        const bool ctx = u.pm < 16;
        const int b = ctx ? u.pm : ((u.pm - 16) >> 3);
        const int sbase = (ctx ? 0 : ((u.pm - 16) & 7) * 256) + wr * 64 + fr;
        const int rbase = u.pm * 256 + wr * 64 + fr;
        const int S = ctx ? 256 : 2048;
        const int dc = wc * 32 + fq * 4;
        const float* rope = (const float*)(ws + W_ROPE);
        const int lay = l;
        half<0>(acc, u, wr, wc, fr, fq, ctx, b, sbase, rbase, S, dc, rope, lay);
        half<1>(acc, u, wr, wc, fr, fq, ctx, b, sbase, rbase, S, dc, rope, lay);
    }
    template <int bj>
    DEVI void half(const f32x4 (&acc)[2][2][4][2], const pg8::Unit& u, int wr, int wc, int fr, int fq, bool ctx, int b, int sbase, int rbase, int S, int dc, const float* rope, int lay) const {
        {
            const int cgi = 2 * u.pn + bj;
            if (cgi >= 54) return;
            auto each = [&](auto f) {
#pragma unroll
                for (int ai = 0; ai < 2; ++ai)
#pragma unroll
                    for (int m = 0; m < 4; ++m)
#pragma unroll
                        for (int n = 0; n < 2; ++n) f(acc[ai][bj][m][n], rbase + 128 * ai + 16 * m, sbase + 128 * ai + 16 * m, n);
            };
            auto tokmaj = [&](bf16_t* base, int stride, int head, float mul) {
                each([&](f32x4 v, int r, int s, int n) { st4(base + (size_t)r * stride + head * 128 + dc + 16 * n, v * mul); });
            };
            auto transp = [&](bf16_t* base, int Hn, int head) {
                bf16_t* bb = base + (ctx ? (size_t)0 : (size_t)16 * Hn * 32768) + (size_t)(b * Hn + head) * 128 * S;
                each([&](f32x4 v, int r, int s, int n) {
#pragma unroll
                    for (int i = 0; i < 4; ++i) bb[(size_t)(dc + 16 * n + i) * S + s] = f2bf1(v[i]);
                });
            };
            auto outf = [&](float* obase, int Hn, int head) {
                float* ob = obase + (size_t)((b * 2 + lay) * Hn + head) * 32768;
                each([&](f32x4 v, int r, int s, int n) { *(f32x4*)(ob + (size_t)s * 128 + dc + 16 * n) = v; });
            };
            if (cgi < 6) {
                tokmaj((bf16_t*)(ws + W_QA), 768, cgi, 1.0f);
            } else if (cgi < 12) {
                tokmaj((bf16_t*)(ws + W_KA), 768, cgi - 6, 1.0f);
                if (ctx) outf(out + O_AK, 6, cgi - 6);
            } else if (cgi < 18) {
                transp((bf16_t*)(ws + W_VAT), 6, cgi - 12);
                if (ctx) outf(out + O_AV, 6, cgi - 12);
            } else if (cgi < 28) {
                const bool isq = cgi < 23;
                const int head = isq ? cgi - 18 : cgi - 23;
                if (isq || ctx) tokmaj((bf16_t*)(ws + (isq ? W_QB : W_KB)), 640, head, 1.0f);
                if (!isq && ctx) outf(out + O_BK, 5, head);
                if (!ctx) {
                    bf16_t* rb = isq ? (bf16_t*)(ws + W_QBR) + (size_t)(rbase - TC) * 640 : (bf16_t*)(ws + W_KB) + (size_t)rbase * 640;
#pragma unroll
                    for (int ai = 0; ai < 2; ++ai)
#pragma unroll
                        for (int m = 0; m < 4; ++m) {
                            const int s = sbase + 128 * ai + 16 * m;
                            const int pos = (wc & 1) ? (s & 63) : (s >> 6);
                            const f32x4 cs = *(const f32x4*)(rope + pos * 16 + 4 * fq), sn = *(const f32x4*)(rope + 1024 + pos * 16 + 4 * fq);
                            const f32x4 x1 = acc[ai][bj][m][0], x2 = acc[ai][bj][m][1];
                            bf16_t* d = rb + (size_t)(128 * ai + 16 * m) * 640 + head * 128 + dc;
                            st4(d, x1 * cs - x2 * sn);
                            st4(d + 16, x1 * sn + x2 * cs);
                        }
                }
            } else if (cgi < 33) {
                transp((bf16_t*)(ws + W_VBT), 5, cgi - 28);
                if (ctx) outf(out + O_BV, 5, cgi - 28);
            } else if (cgi < 38) {
                tokmaj((bf16_t*)(ws + W_QC), 640, cgi - 33, 0.08838834764831845f);
            } else if (cgi < 43) {
                tokmaj((bf16_t*)(ws + W_KC), 640, cgi - 38, 1.0f);
                transp((bf16_t*)(ws + W_KCT), 5, cgi - 38);
            } else if (cgi < 48) {
                transp((bf16_t*)(ws + W_VCT), 5, cgi - 43);
            } else if (cgi < 53) {
                bf16_t* base = (bf16_t*)(ws + W_OG);
                const int head = cgi - 48;
                each([&](f32x4 v, int r, int s, int n) {
                    f32x4 o;
#pragma unroll
                    for (int i = 0; i < 4; ++i) o[i] = sigmoidf_(v[i]);
                    st4(base + (size_t)r * 640 + head * 128 + dc + 16 * n, o);
                });
            } else {
                if (wc == 0) {
                    float* G = (float*)(ws + W_G);
                    each([&](f32x4 v, int r, int s, int n) {
                        if (n == 0 || fq == 0) {
#pragma unroll
                            for (int i = 0; i < 4; ++i) {
                                const int col = 16 * n + 4 * fq + i;
                                float x = v[i] + gate_b[lay * 20 + col];
                                if ((col / 5) & 1) x = fminf(x, 0.f) - log1pf(expf(-fabsf(x)));
                                G[(size_t)r * 20 + col] = x;
                            }
                        }
                    });
                }
            }
        }
    }
};
struct EpiRes {
    static constexpr bool PERM = false, AFTER_DRAIN = false;
    const float* xin_c; const float* xin_l; float* X; const float* gate;
    DEVI void operator()(const f32x4 (&acc)[2][2][4][2], const pg8::Unit& u, int wr, int wc, int fr, int fq) const {
        const int row0 = u.pm * 256 + wr * 64 + fr, col0 = u.pn * 256 + wc * 32 + 4 * fq;
        const float* gr = gate + (size_t)(u.pm < 16 ? 0 : 1 + ((u.pm - 16) >> 3)) * 12288;
        f32x4 gv[2][2];
#pragma unroll
        for (int bj = 0; bj < 2; ++bj)
#pragma unroll
            for (int n = 0; n < 2; ++n) gv[bj][n] = *(const f32x4*)(gr + col0 + bj * 128 + n * 16);
#pragma unroll
        for (int ai = 0; ai < 2; ++ai)
#pragma unroll
            for (int m = 0; m < 4; ++m) {
                const int r = row0 + ai * 128 + m * 16;
                const float* xr = (r < TC ? xin_c + (size_t)r * D : xin_l + (size_t)(r - TC) * D) + col0;
                float* xo = X + (size_t)r * D + col0;
#pragma unroll
                for (int bj = 0; bj < 2; ++bj)
#pragma unroll
                    for (int n = 0; n < 2; ++n) {
                        const f32x4 xv = *(const f32x4*)(xr + bj * 128 + n * 16);
                        *(f32x4*)(xo + bj * 128 + n * 16) = ALPHA * xv + gv[bj][n] * acc[ai][bj][m][n];
                    }
            }
    }
};
struct EpiU {
    static constexpr bool PERM = false, AFTER_DRAIN = false;
    bf16_t* U;
    DEVI void operator()(const f32x4 (&acc)[2][2][4][2], const pg8::Unit& u, int wr, int wc, int fr, int fq) const {
        const int row0 = u.pm * 256 + wr * 64 + fr, col0 = u.pn * 256 + wc * 32 + 4 * fq;
#pragma unroll
        for (int ai = 0; ai < 2; ++ai)
#pragma unroll
            for (int m = 0; m < 4; ++m) {
                bf16_t* ur = U + (size_t)(row0 + ai * 128 + m * 16) * NUP + col0;
#pragma unroll
                for (int bj = 0; bj < 2; ++bj)
#pragma unroll
                    for (int n = 0; n < 2; ++n) st4(ur + bj * 128 + n * 16, acc[ai][bj][m][n]);
            }
    }
};

DEVI void ln_phase(const P& p, int l, int which) {
    const int lane = threadIdx.x & 63, wid = threadIdx.x >> 6;
    float* X = (float*)(p.ws + W_X);
    const float* gam = p.in[which ? I_LN2G : I_LN1G] + l * D;
    const float* bet = p.in[which ? I_LN2B : I_LN1B] + l * D;
    const bool last = which == 1 && l == 1;
    const float* mods = (const float*)(p.ws + W_MODS) + (size_t)(which ? l + 1 : l) * 36864 + (which ? 0 : 3 * 2048);
    bf16_t* H = (bf16_t*)(p.ws + W_H);
    for (int t = blockIdx.x * 8 + wid; t < T; t += gridDim.x * 8) {
        const float* src = X + (size_t)t * D;
        f32x4 v[8];
        float s = 0.f;
#pragma unroll
        for (int j = 0; j < 8; ++j) { v[j] = *(const f32x4*)(src + 4 * lane + 256 * j); s += v[j][0] + v[j][1] + v[j][2] + v[j][3]; }
        const float mu = wave_sum(s) * (1.0f / D);
        float q = 0.f;
#pragma unroll
        for (int j = 0; j < 8; ++j) { v[j] -= mu; q += v[j][0] * v[j][0] + v[j][1] * v[j][1] + v[j][2] * v[j][2] + v[j][3] * v[j][3]; }
        const float rstd = rsqrtf(wave_sum(q) * (1.0f / D) + 1e-5f);
        float* dst = last ? p.out + O_Y + (size_t)t * D : X + (size_t)t * D;
        const float* mr = mods + (size_t)cond_of_row(t) * 12288;
#pragma unroll
        for (int j = 0; j < 8; ++j) {
            const int c = 4 * lane + 256 * j;
            const f32x4 y = v[j] * rstd * *(const f32x4*)(gam + c) + *(const f32x4*)(bet + c);
            *(f32x4*)(dst + c) = y;
            if (!last) st4(H + (size_t)t * D + c, y * (1.0f + *(const f32x4*)(mr + 2048 + c)) + *(const f32x4*)(mr + c));
        }
    }
}

DEVI void conv_phase(const P& p, int l) {
    const bf16_t* U = (const bf16_t*)(p.ws + W_U);
    bf16_t* A = (bf16_t*)(p.ws + W_ACT);
    const float* cw = p.in[I_CONVW] + (size_t)l * 3 * NUP;
    const float* cb = p.in[I_CONVB] + (size_t)l * NUP;
    for (int id = blockIdx.x * blockDim.x + threadIdx.x; id < 256 * 688; id += gridDim.x * blockDim.x) {
        const int trun = id / 688, cgp = id % 688, j0 = cgp * 8, t0 = trun * 32;
        const int S = t0 < TC ? 256 : 2048;
        const int s0 = t0 < TC ? (t0 & 255) : ((t0 - TC) & 2047);
        float wa[3][8], wg[3][8], ba[8], bg[8];
#pragma unroll
        for (int k = 0; k < 3; ++k)
#pragma unroll
            for (int h = 0; h < 2; ++h) {
                const f32x4 x = *(const f32x4*)(cw + (size_t)k * NUP + j0 + 4 * h), y = *(const f32x4*)(cw + (size_t)k * NUP + DFF + j0 + 4 * h);
#pragma unroll
                for (int i = 0; i < 4; ++i) { wa[k][4 * h + i] = x[i]; wg[k][4 * h + i] = y[i]; }
            }
#pragma unroll
        for (int h = 0; h < 2; ++h) {
            const f32x4 x = *(const f32x4*)(cb + j0 + 4 * h), y = *(const f32x4*)(cb + DFF + j0 + 4 * h);
#pragma unroll
            for (int i = 0; i < 4; ++i) { ba[4 * h + i] = x[i]; bg[4 * h + i] = y[i]; }
        }
        const u32x4 zero = {0u, 0u, 0u, 0u};
        auto lda = [&](int t) { return *(const u32x4*)(U + (size_t)t * NUP + j0); };
        auto ldg = [&](int t) { return *(const u32x4*)(U + (size_t)t * NUP + DFF + j0); };
        u32x4 pa = s0 > 0 ? lda(t0 - 1) : zero, pg = s0 > 0 ? ldg(t0 - 1) : zero;
        u32x4 ca = lda(t0), cgv = ldg(t0);
        for (int i = 0; i < 32; ++i) {
            const int t = t0 + i;
            const bool hn = (s0 + i + 1) < S;
            const u32x4 na = hn ? lda(t + 1) : zero, ng = hn ? ldg(t + 1) : zero;
            float o[8];
#pragma unroll
            for (int w = 0; w < 4; ++w) {
                const float a0 = wa[0][2 * w] * bflo(pa[w]) + wa[1][2 * w] * bflo(ca[w]) + wa[2][2 * w] * bflo(na[w]) + ba[2 * w];
                const float a1 = wa[0][2 * w + 1] * bfhi(pa[w]) + wa[1][2 * w + 1] * bfhi(ca[w]) + wa[2][2 * w + 1] * bfhi(na[w]) + ba[2 * w + 1];
                const float g0 = wg[0][2 * w] * bflo(pg[w]) + wg[1][2 * w] * bflo(cgv[w]) + wg[2][2 * w] * bflo(ng[w]) + bg[2 * w];
                const float g1 = wg[0][2 * w + 1] * bfhi(pg[w]) + wg[1][2 * w + 1] * bfhi(cgv[w]) + wg[2][2 * w + 1] * bfhi(ng[w]) + bg[2 * w + 1];
                o[2 * w] = siluf_(g0) * a0; o[2 * w + 1] = siluf_(g1) * a1;
            }
            const u32x4 ov = {cvt_pk_bf16(o[0], o[1]), cvt_pk_bf16(o[2], o[3]), cvt_pk_bf16(o[4], o[5]), cvt_pk_bf16(o[6], o[7])};
            *(u32x4*)(A + (size_t)t * DFF + j0) = ov;
            pa = ca; pg = cgv; ca = na; cgv = ng;
        }
    }
}

constexpr size_t LATV_A = (size_t)16 * 6 * 32768, LATV_B = (size_t)16 * 5 * 32768;
template <bool DIFF>
DEVI void attn_item(const bf16_t* qrow0, const bf16_t* qrow1,
                    const bf16_t* K0, int ks0, int kstart0, int tstep0, int nt0, const bf16_t* VT0, int vs0,
                    const bf16_t* K1, int ks1, int nt1, const bf16_t* VT1, int vs1,
                    bool neigh, int qr, int qc0, int c0, int rs, const float* rpb_h,
                    float sc2, bf16_t* yrow, float lam, const float* subln, float outscale) {
    constexpr int NMAP = DIFF ? 2 : 1, NKK = DIFF ? 2 : 4;
    const int lane = threadIdx.x & 63, l16 = lane & 15, g = lane >> 4;
    float mrun[NMAP], lrun[NMAP];
    f32x4 o[NMAP][8];
#pragma unroll
    for (int mp = 0; mp < NMAP; ++mp) {
        mrun[mp] = -1e30f; lrun[mp] = 0.f;
#pragma unroll
        for (int dt = 0; dt < 8; ++dt) o[mp][dt] = (f32x4){0.f, 0.f, 0.f, 0.f};
    }
    bf16x8 qf[NMAP][NKK];
#pragma unroll
    for (int mp = 0; mp < NMAP; ++mp)
#pragma unroll
        for (int kk = 0; kk < NKK; ++kk) qf[mp][kk] = ld8(qrow0 + (mp * NKK + kk) * 32 + 8 * g);
    const int qc = qc0 + l16, cs = clampi(qc - 8, 0, 48);
    const int ntot = nt0 + nt1;
    for (int j = 0; j < ntot; ++j) {
        const bool s0 = j < nt0;
        if (j == nt0 && qrow1 != qrow0) {
#pragma unroll
            for (int mp = 0; mp < NMAP; ++mp)
#pragma unroll
                for (int kk = 0; kk < NKK; ++kk) qf[mp][kk] = ld8(qrow1 + (mp * NKK + kk) * 32 + 8 * g);
        }
        const int key0 = s0 ? kstart0 + j * tstep0 : (j - nt0) * 32;
        const int ks = s0 ? ks0 : ks1, vs = s0 ? vs0 : vs1;
        const bf16_t* Kt = (s0 ? K0 : K1) + (size_t)key0 * ks + (size_t)l16 * ks + 8 * g;
        const bf16_t* Vt = (s0 ? VT0 : VT1) + key0 + (size_t)l16 * vs + 4 * g;
        f32x4 s[NMAP][2];
#pragma unroll
        for (int mp = 0; mp < NMAP; ++mp)
#pragma unroll
            for (int half = 0; half < 2; ++half) {
                f32x4 a = {0.f, 0.f, 0.f, 0.f};
#pragma unroll
                for (int kk = 0; kk < NKK; ++kk) a = mfma16(ld8(Kt + (size_t)(16 * half) * ks + (mp * NKK + kk) * 32), qf[mp][kk], a);
                s[mp][half] = a;
            }
        bf16x8 vf[8];
#pragma unroll
        for (int dt = 0; dt < 8; ++dt) vf[dt] = ld4x2(Vt + (size_t)(16 * dt) * vs, Vt + (size_t)(16 * dt) * vs + 16);
#pragma unroll
        for (int mp = 0; mp < NMAP; ++mp) {
            float v[8];
#pragma unroll
            for (int half = 0; half < 2; ++half)
#pragma unroll
                for (int i = 0; i < 4; ++i) v[half * 4 + i] = s[mp][half][i] * sc2;
            if (neigh && s0) {
                const float* brow = rpb_h + (7 + rs + j - qr) * 31;
#pragma unroll
                for (int half = 0; half < 2; ++half)
#pragma unroll
                    for (int i = 0; i < 4; ++i) {
                        const int kc = c0 + 16 * half + 4 * g + i;
                        const bool ok = kc >= cs && kc < cs + 16;
                        const float bv = brow[clampi(kc - qc + 15, 0, 30)] * LOG2E;
                        v[half * 4 + i] = ok ? v[half * 4 + i] + bv : -1e30f;
                    }
            }
            float tm = fmaxf(fmaxf(fmaxf(v[0], v[1]), fmaxf(v[2], v[3])), fmaxf(fmaxf(v[4], v[5]), fmaxf(v[6], v[7])));
            tm = fmaxf(tm, __shfl_xor(tm, 16)); tm = fmaxf(tm, __shfl_xor(tm, 32));
            const float mnew = fmaxf(mrun[mp], tm), alpha = ex2(mrun[mp] - mnew);
            mrun[mp] = mnew;
            f32x4 p0, p1; float ps = 0.f;
#pragma unroll
            for (int i = 0; i < 4; ++i) { p0[i] = ex2(v[i] - mnew); p1[i] = ex2(v[4 + i] - mnew); ps += p0[i] + p1[i]; }
            lrun[mp] = lrun[mp] * alpha + ps;
            const bf16x8 pb = pack8(p0, p1);
#pragma unroll
            for (int dt = 0; dt < 8; ++dt) o[mp][dt] = mfma16(vf[dt], pb, o[mp][dt] * alpha);
        }
    }
    float inv[NMAP];
#pragma unroll
    for (int mp = 0; mp < NMAP; ++mp) { float lsum = lrun[mp]; lsum += __shfl_xor(lsum, 16); lsum += __shfl_xor(lsum, 32); inv[mp] = 1.0f / lsum; }
    if constexpr (!DIFF) {
#pragma unroll
        for (int dt = 0; dt < 8; ++dt) st4(yrow + 16 * dt + 4 * g, o[0][dt] * inv[0]);
    } else {
        float ss = 0.f;
        f32x4 ov[8];
#pragma unroll
        for (int dt = 0; dt < 8; ++dt) {
            ov[dt] = o[0][dt] * inv[0] - (lam * inv[1]) * o[1][dt];
            ss += ov[dt][0] * ov[dt][0] + ov[dt][1] * ov[dt][1] + ov[dt][2] * ov[dt][2] + ov[dt][3] * ov[dt][3];
        }
        ss += __shfl_xor(ss, 16); ss += __shfl_xor(ss, 32);
        const float rinv = rsqrtf(ss * (1.0f / 128.0f) + 1e-6f) * outscale;
#pragma unroll
        for (int dt = 0; dt < 8; ++dt) st4(yrow + 16 * dt + 4 * g, ov[dt] * rinv * *(const f32x4*)(subln + 16 * dt + 4 * g));
    }
}

DEVI float incl_scan_sum(float v, int lane) {
#pragma unroll
    for (int o = 1; o < 64; o <<= 1) { const float t = __shfl_up(v, o); if (lane >= o) v += t; }
    return v;
}
DEVI float incl_scan_max(float v, int lane) {
#pragma unroll
    for (int o = 1; o < 64; o <<= 1) { const float t = __shfl_up(v, o); if (lane >= o) v = fmaxf(v, t); }
    return v;
}
DEVI bf16x8 ones_row(int l16) { const short v = (short)(l16 == 0 ? 0x3F80 : 0); return (bf16x8){v, v, v, v, v, v, v, v}; }
DEVI bf16x8 ldf8(const float* p) { return pack8(*(const f32x4*)p, *(const f32x4*)(p + 4)); }

DEVI void m1_item(const P& p, int item) {
    const int lane = threadIdx.x & 63, l16 = lane & 15, g = lane >> 4;
    const int slot = item >> 3, dt = item & 7;
    int chunk, dir, bh, tok0, vs; size_t tb;
    if (slot < 640) { chunk = slot & 3; dir = (slot >> 2) & 1; bh = slot >> 3; tok0 = (bh / 5) * 256 + chunk * 64; vs = 256; tb = (size_t)bh * 128 * 256 + chunk * 64; }
    else { const int q = slot - 640; chunk = q & 31; dir = (q >> 5) & 1; bh = q >> 6; tok0 = TC + (bh / 5) * 2048 + chunk * 64; vs = 2048; tb = LATV_B + (size_t)bh * 128 * 2048 + chunk * 64; }
    const int h = bh % 5;
    const float* G = (const float*)(p.ws + W_G) + (size_t)(tok0 + lane) * 20;
    const float f = G[(dir ? 15 : 5) + h], ig = G[(dir ? 10 : 0) + h];
    const float ps = incl_scan_sum(f, lane), total = __shfl(ps, 63);
    const float gs = (dir ? ps - f : total - ps) + ig;
    const float mloc = wave_max(gs), w = __expf(gs - mloc);
    const bf16_t* kct = (const bf16_t*)(p.ws + W_KCT) + tb + (size_t)(16 * dt + l16) * vs + 8 * g;
    const bf16_t* vct = (const bf16_t*)(p.ws + W_VCT) + tb + (size_t)l16 * vs + 8 * g;
    bf16x8 bk[2];
#pragma unroll
    for (int ks = 0; ks < 2; ++ks) {
        const u32x4 raw = *(const u32x4*)(kct + 32 * ks);
        float wv[8];
#pragma unroll
        for (int j = 0; j < 8; ++j) wv[j] = __shfl(w, 32 * ks + 8 * g + j);
        const u32x4 r = {cvt_pk_bf16(bflo(raw[0]) * wv[0], bfhi(raw[0]) * wv[1]), cvt_pk_bf16(bflo(raw[1]) * wv[2], bfhi(raw[1]) * wv[3]),
                         cvt_pk_bf16(bflo(raw[2]) * wv[4], bfhi(raw[2]) * wv[5]), cvt_pk_bf16(bflo(raw[3]) * wv[6], bfhi(raw[3]) * wv[7])};
        bk[ks] = __builtin_bit_cast(bf16x8, r);
    }
    float* ST = (float*)(p.ws + W_ST) + (size_t)slot * 16384 + 16 * dt + l16;
#pragma unroll
    for (int et = 0; et < 8; ++et) {
        f32x4 a = {0.f, 0.f, 0.f, 0.f};
#pragma unroll
        for (int ks = 0; ks < 2; ++ks) a = mfma16(ld8(vct + (size_t)(16 * et) * vs + 32 * ks), bk[ks], a);
#pragma unroll
        for (int i = 0; i < 4; ++i) ST[(16 * et + 4 * g + i) * 128] = a[i];
    }
    {
        f32x4 a = {0.f, 0.f, 0.f, 0.f};
        const bf16x8 on = ones_row(l16);
#pragma unroll
        for (int ks = 0; ks < 2; ++ks) a = mfma16(on, bk[ks], a);
        if (g == 0) ((float*)(p.ws + W_SN))[(size_t)slot * 128 + 16 * dt + l16] = a[0];
    }
    if (dt == 0 && lane == 0) { float* SS = (float*)(p.ws + W_SS); SS[slot] = total; SS[1920 + slot] = mloc; }
}

DEVI void m2_phase(const P& p, int l) {
    const int tid = threadIdx.x;
    float* SS = (float*)(p.ws + W_SS);
    for (int it = blockIdx.x; it < 180 * 9; it += gridDim.x) {
        const int sd = it / 9, slice = it % 9;
        const bool lat = sd < 20;
        const int q = lat ? sd : sd - 20, dir = q & 1, bh = q >> 1, b = bh / 5, h = bh % 5;
        const int nc = lat ? 32 : 4, slot0 = lat ? 640 + (bh * 2 + dir) * 32 : (bh * 2 + dir) * 4;
        const size_t sidx = (size_t)((b * 2 + l) * 2 + dir) * 5 + h;
        float m = lat ? p.in[I_SM][sidx] : 0.f;
        const bool act = slice < 8 || tid < 32;
        const int eo = slice < 8 ? slice * 2048 + tid * 4 : 0;
        const int e = eo >> 7, d0 = slice < 8 ? (eo & 127) : tid * 4;
        f32x4 C = {0.f, 0.f, 0.f, 0.f};
        if (lat && act) {
            if (slice < 8) { const float* ci = p.in[I_SC] + sidx * 16384;
#pragma unroll
                for (int i = 0; i < 4; ++i) C[i] = ci[(d0 + i) * 128 + e]; }
            else C = *(const f32x4*)(p.in[I_SN] + sidx * 128 + d0);
        }
        float* base = slice < 8 ? (float*)(p.ws + W_ST) + eo : (float*)(p.ws + W_SN) + d0;
        const size_t sstride = slice < 8 ? 16384 : 128;
        f32x4 kvn = {0.f, 0.f, 0.f, 0.f};
        { const int j0 = dir ? nc - 1 : 0; if (act) kvn = *(const f32x4*)(base + (size_t)(slot0 + j0) * sstride); }
        for (int jj = 0; jj < nc; ++jj) {
            const int j = dir ? nc - 1 - jj : jj, slot = slot0 + j;
            const f32x4 kv = kvn;
            if (jj + 1 < nc && act) { const int jn = dir ? nc - 2 - jj : jj + 1; kvn = *(const f32x4*)(base + (size_t)(slot0 + jn) * sstride); }
            const float bl = SS[slot], ml = SS[1920 + slot];
            const float mnew = fmaxf(bl + m, ml), wold = __expf(bl + m - mnew), wnew = __expf(ml - mnew);
            if (act) *(f32x4*)(base + (size_t)slot * sstride) = C;
            if (slice == 0 && tid == 0) SS[2 * 1920 + slot] = m;
            C = wold * C + wnew * kv;
            m = mnew;
        }
        if (!lat && act) {
            if (slice < 8) { float* co = p.out + O_CC + sidx * 16384;
#pragma unroll
                for (int i = 0; i < 4; ++i) co[(d0 + i) * 128 + e] = C[i]; }
            else *(f32x4*)(p.out + O_CN + sidx * 128 + d0) = C;
            if (slice == 0 && tid == 0) p.out[O_CM + sidx] = m;
        }
    }
}

DEVI void m3_item(const P& p, int l, int idx) {
    const int lane = threadIdx.x & 63, l16 = lane & 15, g = lane >> 4;
    const int tt = idx & 3, cidx = idx >> 2;
    int bh, chunk, tok0, vs, slotf, slotb; size_t tb;
    if (cidx < 320) { bh = cidx >> 2; chunk = cidx & 3; tok0 = (bh / 5) * 256 + chunk * 64; vs = 256; tb = (size_t)bh * 128 * 256 + chunk * 64; slotf = (bh * 2) * 4 + chunk; slotb = (bh * 2 + 1) * 4 + chunk; }
    else { const int q = cidx - 320; bh = q >> 5; chunk = q & 31; tok0 = TC + (bh / 5) * 2048 + chunk * 64; vs = 2048; tb = LATV_B + (size_t)bh * 128 * 2048 + chunk * 64; slotf = 640 + (bh * 2) * 32 + chunk; slotb = 640 + (bh * 2 + 1) * 32 + chunk; }
    const int h = bh % 5, tq = 16 * tt + l16;
    const bf16_t* qrow = (const bf16_t*)(p.ws + W_QC) + (size_t)(tok0 + tq) * 640 + h * 128 + 8 * g;
    bf16x8 qf[4];
#pragma unroll
    for (int kk = 0; kk < 4; ++kk) qf[kk] = ld8(qrow + 32 * kk);
    f32x4 sT[4];
    {
        const bf16_t* kb = (const bf16_t*)(p.ws + W_KC) + (size_t)(tok0 + l16) * 640 + h * 128 + 8 * g;
#pragma unroll
        for (int st = 0; st < 4; ++st) {
            f32x4 a = {0.f, 0.f, 0.f, 0.f};
#pragma unroll
            for (int kk = 0; kk < 4; ++kk) a = mfma16(ld8(kb + (size_t)(16 * st) * 640 + 32 * kk), qf[kk], a);
            sT[st] = a;
        }
    }
    f32x4 hsum[8];
#pragma unroll
    for (int et = 0; et < 8; ++et) hsum[et] = (f32x4){0.f, 0.f, 0.f, 0.f};
    const float* Gp = (const float*)(p.ws + W_G) + (size_t)(tok0 + lane) * 20;
    const float* SS = (const float*)(p.ws + W_SS);
    const bf16_t* vtb = (const bf16_t*)(p.ws + W_VCT) + tb + (size_t)l16 * vs + 4 * g;
    for (int dir = 0; dir < 2; ++dir) {
        const int slot = dir ? slotb : slotf;
        float f = Gp[(dir ? 15 : 5) + h], ig = Gp[(dir ? 10 : 0) + h];
        if (dir) { f = __shfl(f, 63 - lane); ig = __shfl(ig, 63 - lane); }
        const float bs = incl_scan_sum(f, lane);
        float a_ = ig - bs;
        const float pm = incl_scan_max(a_, lane);
        const float mst = SS[2 * 1920 + slot];
        const float mrow = bs + fmaxf(pm, mst);
        float c_ = bs - mrow, wst = __expf(bs + mst - mrow), emr = __expf(-mrow);
        if (dir) { a_ = __shfl(a_, 63 - lane); c_ = __shfl(c_, 63 - lane); wst = __shfl(wst, 63 - lane); emr = __shfl(emr, 63 - lane); }
        const float cq = __shfl(c_, tq), wq = __shfl(wst, tq), eq = __shfl(emr, tq);
        f32x4 o[9];
        const float* Cs = (const float*)(p.ws + W_ST) + (size_t)slot * 16384 + (size_t)l16 * 128 + 8 * g;
#pragma unroll
        for (int et = 0; et < 8; ++et) {
            f32x4 a = {0.f, 0.f, 0.f, 0.f};
#pragma unroll
            for (int kk = 0; kk < 4; ++kk) a = mfma16(ldf8(Cs + (size_t)(16 * et) * 128 + 32 * kk), qf[kk], a);
            o[et] = a * wq;
        }
        {
            const float* ns = (const float*)(p.ws + W_SN) + (size_t)slot * 128 + 8 * g;
            f32x4 a = {0.f, 0.f, 0.f, 0.f};
#pragma unroll
            for (int kk = 0; kk < 4; ++kk) {
                bf16x8 nf = ldf8(ns + 32 * kk);
                if (l16 != 0) nf = (bf16x8){0, 0, 0, 0, 0, 0, 0, 0};
                a = mfma16(nf, qf[kk], a);
            }
            o[8] = a * wq;
        }
        const bf16x8 on = ones_row(l16);
#pragma unroll
        for (int ks = 0; ks < 2; ++ks) {
            f32x4 pp[2];
#pragma unroll
            for (int half = 0; half < 2; ++half) {
                const int st = 2 * ks + half;
#pragma unroll
                for (int i = 0; i < 4; ++i) {
                    const int s = 16 * st + 4 * g + i;
                    const float as = __shfl(a_, s);
                    const bool ok = dir ? (s >= tq) : (s <= tq);
                    pp[half][i] = ok ? sT[st][i] * __expf(as + cq) : 0.f;
                }
            }
            const bf16x8 pb = pack8(pp[0], pp[1]);
#pragma unroll
            for (int et = 0; et < 8; ++et) o[et] = mfma16(ld4x2(vtb + (size_t)(16 * et) * vs + 32 * ks, vtb + (size_t)(16 * et) * vs + 32 * ks + 16), pb, o[et]);
            o[8] = mfma16(on, pb, o[8]);
        }
        const float den = __shfl(o[8][0], l16);
        const float dinv = 1.0f / fmaxf(fabsf(den), eq);
#pragma unroll
        for (int et = 0; et < 8; ++et) hsum[et] += o[et] * dinv;
    }
    float ss = 0.f;
#pragma unroll
    for (int et = 0; et < 8; ++et) ss += hsum[et][0] * hsum[et][0] + hsum[et][1] * hsum[et][1] + hsum[et][2] * hsum[et][2] + hsum[et][3] * hsum[et][3];
    ss += __shfl_xor(ss, 16); ss += __shfl_xor(ss, 32);
    const float rinv = rsqrtf(ss * (1.0f / 128.0f) + 1e-6f);
    const bf16_t* og = (const bf16_t*)(p.ws + W_OG) + (size_t)(tok0 + tq) * 640 + h * 128 + 4 * g;
    const float* cn = p.in[I_CNORM] + l * 128 + 4 * g;
    bf16_t* y = (bf16_t*)(p.ws + W_Y) + (size_t)(tok0 + tq) * D + 1408 + h * 128 + 4 * g;
#pragma unroll
    for (int et = 0; et < 8; ++et) {
        const u32x2 ou = *(const u32x2*)(og + 16 * et);
        const f32x4 ogf = {bflo(ou[0]), bfhi(ou[0]), bflo(ou[1]), bfhi(ou[1])};
        st4(y + 16 * et, hsum[et] * rinv * *(const f32x4*)(cn + 16 * et) * ogf);
    }
}

constexpr int N_BL = 1280, N_AL = 1536, N_M3 = 2560, N_AC = 1536, N_BC = 1280, N_MIX = N_BL + N_AL + N_M3 + N_AC + N_BC;
DEVI void mixer_phase(const P& p, int l) {
    const int lane = threadIdx.x & 63, l16 = lane & 15;
    char* ws = p.ws;
    unsigned* cnt = (unsigned*)(ws + W_CNT) + 64 * l;
    const float lam_init = l == 0 ? 0.2f : 0.35550906759f;
    float lam;
    {
        const float* bl = p.in[I_LAMBDA] + l * 256;
        const float s1 = wave_sum(bl[lane] * bl[64 + lane]), s2 = wave_sum(bl[128 + lane] * bl[192 + lane]);
        lam = expf(s1) - expf(s2) + lam_init;
    }
    const bf16_t* Qa = (const bf16_t*)(ws + W_QA); const bf16_t* Ka = (const bf16_t*)(ws + W_KA); const bf16_t* VaT = (const bf16_t*)(ws + W_VAT);
    const bf16_t* Qb = (const bf16_t*)(ws + W_QB); const bf16_t* Qbr = (const bf16_t*)(ws + W_QBR); const bf16_t* Kb = (const bf16_t*)(ws + W_KB); const bf16_t* VbT = (const bf16_t*)(ws + W_VBT);
    bf16_t* Y = (bf16_t*)(ws + W_Y);
    const float scA = 0.08838834764831845f * LOG2E, scB = 0.125f * LOG2E;
    const float* subln = p.in[I_SUBLN] + l * 128;
    for (;;) {
        unsigned it = 0;
        if (lane == 0) it = atomicAdd(cnt, 1u);
        it = (unsigned)__builtin_amdgcn_readfirstlane((int)it);
        if (it >= (unsigned)N_MIX) break;
        int idx = (int)it;
        if (idx < N_BL) {
            const int b = idx / 640, h = (idx % 640) / 128, qt = idx % 128;
            const int tl = b * 2048 + qt * 16 + l16, t = TC + tl;
            attn_item<true>(Qbr + (size_t)tl * 640 + h * 128, Qb + (size_t)t * 640 + h * 128,
                            Kb + (size_t)(TC + b * 2048) * 640 + h * 128, 640, 0, 32, 64, VbT + LATV_B + (size_t)(b * 5 + h) * 128 * 2048, 2048,
                            (const bf16_t*)(ws + W_CKB) + (size_t)((b * 2 + l) * 5 + h) * 65536, 128, 16, (const bf16_t*)(ws + W_CVB) + (size_t)((b * 2 + l) * 5 + h) * 65536, 512,
                            false, 0, 0, 0, 0, nullptr, scB, Y + (size_t)t * D + 768 + h * 128, lam, subln, 1.0f - lam_init);
            continue;
        }
        idx -= N_BL;
        if (idx < N_AL) {
            const int b = idx / 768, h = (idx % 768) / 128, r = (idx % 128) / 4, q4 = idx % 4;
            const int qc0 = 16 * q4, c0 = clampi(qc0 - 8, 0, 32), rs = clampi(r - 4, 0, 24);
            const int t = TC + b * 2048 + r * 64 + qc0 + l16;
            const bf16_t* qrow = Qa + (size_t)t * 768 + h * 128;
            attn_item<false>(qrow, qrow, Ka + (size_t)(TC + b * 2048) * 768 + h * 128, 768, rs * 64 + c0, 64, 8, VaT + LATV_A + (size_t)(b * 6 + h) * 128 * 2048, 2048,
                             (const bf16_t*)(ws + W_CKA) + (size_t)((b * 2 + l) * 6 + h) * 65536, 128, 16, (const bf16_t*)(ws + W_CVA) + (size_t)((b * 2 + l) * 6 + h) * 65536, 512,
                             true, r, qc0, c0, rs, p.in[I_RPB] + (size_t)(l * 6 + h) * 465, scA, Y + (size_t)t * D + h * 128, 0.f, nullptr, 1.0f);
            continue;
        }
        idx -= N_AL;
        if (idx < N_M3) { m3_item(p, l, idx); continue; }
        idx -= N_M3;
        if (idx < N_AC) {
            const int b = idx / 96, h = (idx % 96) / 16, qt = idx % 16;
            const int t = b * 256 + qt * 16 + l16;
            const bf16_t* qrow = Qa + (size_t)t * 768 + h * 128;
            attn_item<false>(qrow, qrow, Ka + (size_t)(b * 256) * 768 + h * 128, 768, 0, 32, 8, VaT + (size_t)(b * 6 + h) * 128 * 256, 256,
                             nullptr, 0, 0, nullptr, 0, false, 0, 0, 0, 0, nullptr, scA, Y + (size_t)t * D + h * 128, 0.f, nullptr, 1.0f);
            continue;
        }
        idx -= N_AC;
        {
            const int b = idx / 80, h = (idx % 80) / 16, qt = idx % 16;
            const int t = b * 256 + qt * 16 + l16;
            const bf16_t* qrow = Qb + (size_t)t * 640 + h * 128;
            attn_item<true>(qrow, qrow, Kb + (size_t)(b * 256) * 640 + h * 128, 640, 0, 32, 8, VbT + (size_t)(b * 5 + h) * 128 * 256, 256,
                            nullptr, 0, 0, nullptr, 0, false, 0, 0, 0, 0, nullptr, scB, Y + (size_t)t * D + 768 + h * 128, lam, subln, 1.0f - lam_init);
        }
    }
}

constexpr int NPHASE = 23;
#ifndef PH_END
#define PH_END NPHASE
#endif
DEVI int kind_of_phase(int ph) {
    if (ph < 3) return ph;
    const int k = (ph - 3) % 10;
    return k == 0 ? 3 : k == 1 ? 4 : k == 2 ? 5 : k == 3 ? 6 : (k == 4 || k == 8) ? 7 : (k == 5 || k == 9) ? 8 : k == 6 ? 9 : 10;
}
template <unsigned MASK>
__global__ __launch_bounds__(512, 2) void fwd_kernel(P p) {
    extern __shared__ __attribute__((aligned(16))) unsigned char shm[];
    cg::grid_group grid = cg::this_grid();
    PG8_LAS unsigned char* lds = (PG8_LAS unsigned char*)shm;
    char* ws = p.ws;
    for (int ph = p.ph_lo; ph < p.ph_hi; ++ph) {
        const int kind = kind_of_phase(ph);
        const int l = ph < 3 ? 0 : (ph - 3) / 10, k = ph < 3 ? 0 : (ph - 3) % 10;
        const float* mods = (const float*)(ws + W_MODS) + (size_t)l * 36864;
        pg8::StaticOrder S;
        if constexpr ((MASK >> 0) & 1) if (kind == 0) phase0a(p, (float*)shm);
        if constexpr ((MASK >> 1) & 1) if (kind == 1) phase0b(p);
        if constexpr ((MASK >> 2) & 1) if (kind == 2) phase0c(p);
        if constexpr ((MASK >> 3) & 1) if (kind == 3) {
            pg8::Gemm g{(const bf16_t*)(ws + W_H), (const bf16_t*)(ws + W_WIN) + (size_t)l * NINP * D, T, NINP, D};
            S.init(T, NINP, (int)gridDim.x, (int)blockIdx.x);
            EpiIn E{ws, p.out, p.in[I_GATEB], l};
            pg8::gemm_phase<EpiIn, pg8::StaticOrder>(lds, g, S, E);
        }
        if constexpr ((MASK >> 4) & 1) if (kind == 4) {
            for (int it = blockIdx.x * 8 + (threadIdx.x >> 6); it < 1280 * 8; it += gridDim.x * 8) m1_item(p, it);
        }
        if constexpr ((MASK >> 5) & 1) if (kind == 5) m2_phase(p, l);
        if constexpr ((MASK >> 6) & 1) if (kind == 6) mixer_phase(p, l);
        if constexpr ((MASK >> 7) & 1) if (kind == 7) {
            if (k == 4) {
                pg8::Gemm g{(const bf16_t*)(ws + W_Y), (const bf16_t*)(ws + W_WOUT) + (size_t)l * D * D, T, D, D};
                S.init(T, D, (int)gridDim.x, (int)blockIdx.x);
                EpiRes E{l == 0 ? p.in[I_XP] : (const float*)(ws + W_X), l == 0 ? p.in[I_XS] : (const float*)(ws + W_X) + (size_t)TC * D, (float*)(ws + W_X), mods + 2 * 2048};
                pg8::gemm_phase<EpiRes, pg8::StaticOrder>(lds, g, S, E);
            } else {
                pg8::Gemm g{(const bf16_t*)(ws + W_ACT), (const bf16_t*)(ws + W_WDN) + (size_t)l * D * DFF, T, D, DFF};
                S.init(T, D, (int)gridDim.x, (int)blockIdx.x);
                EpiRes E{(const float*)(ws + W_X), (const float*)(ws + W_X) + (size_t)TC * D, (float*)(ws + W_X), mods + 5 * 2048};
                pg8::gemm_phase<EpiRes, pg8::StaticOrder>(lds, g, S, E);
            }
        }
        if constexpr ((MASK >> 8) & 1) if (kind == 8) ln_phase(p, l, k == 5 ? 0 : 1);
        if constexpr ((MASK >> 9) & 1) if (kind == 9) {
            pg8::Gemm g{(const bf16_t*)(ws + W_H), (const bf16_t*)(ws + W_WUP) + (size_t)l * NUP * D, T, NUP, D};
            S.init(T, NUP, (int)gridDim.x, (int)blockIdx.x);
            EpiU E{(bf16_t*)(ws + W_U)};
            pg8::gemm_phase<EpiU, pg8::StaticOrder>(lds, g, S, E);
        }
        if constexpr ((MASK >> 10) & 1) if (kind == 10) conv_phase(p, l);
        if (ph + 1 < p.ph_hi) grid.sync();
    }
}

static int host_kind_of_phase(int ph) {
    if (ph < 3) return ph;
    const int k = (ph - 3) % 10;
    return k == 0 ? 3 : k == 1 ? 4 : k == 2 ? 5 : k == 3 ? 6 : (k == 4 || k == 8) ? 7 : (k == 5 || k == 9) ? 8 : k == 6 ? 9 : 10;
}
typedef void (*kern_t)(P);
extern "C" void kernel_launch(void* const* d_in, const int* in_sizes, int n_in, void* d_out, int out_size, void* d_ws, size_t ws_size, hipStream_t stream) {
    constexpr size_t kDynLds = 131072;
    static int grid_blocks = 0;
#if ONE_LAUNCH
    static kern_t kerns[1] = {fwd_kernel<0x7ffu>};
    constexpr int NK = 1;
#else
    static kern_t kerns[11] = {fwd_kernel<1u>, fwd_kernel<2u>, fwd_kernel<4u>, fwd_kernel<8u>, fwd_kernel<16u>, fwd_kernel<32u>, fwd_kernel<64u>, fwd_kernel<128u>, fwd_kernel<256u>, fwd_kernel<512u>, fwd_kernel<1024u>};
    constexpr int NK = 11;
#endif
    if (!grid_blocks) {
        int dev = 0, cus = 0, per_cu = 8;
        (void)hipGetDevice(&dev);
        (void)hipDeviceGetAttribute(&cus, hipDeviceAttributeMultiprocessorCount, dev);
        for (int i = 0; i < NK; ++i) {
            int pc = 0;
            (void)hipFuncSetAttribute((const void*)kerns[i], hipFuncAttributeMaxDynamicSharedMemorySize, (int)kDynLds);
            (void)hipOccupancyMaxActiveBlocksPerMultiprocessor(&pc, kerns[i], 512, kDynLds);
            if (pc < per_cu) per_cu = pc;
        }
        if (per_cu < 1) per_cu = 1;
        grid_blocks = cus * per_cu;
        if (ws_size < W_END) fprintf(stderr, "workspace too small: %zu < %zu\n", ws_size, (size_t)W_END);
    }
    P p{};
    for (int i = 0; i < 28; ++i) p.in[i] = (const float*)d_in[i];
    p.out = (float*)d_out;
    p.ws = (char*)d_ws;
    (void)hipMemsetAsync((char*)d_ws + W_CNT, 0, 4096, stream);
#if ONE_LAUNCH
    p.ph_lo = 0; p.ph_hi = NPHASE;
    void* args[] = {&p};
    hipError_t e = hipLaunchCooperativeKernel((const void*)kerns[0], dim3(grid_blocks), dim3(512), args, kDynLds, stream);
    if (e != hipSuccess) fprintf(stderr, "cooperative launch failed: %s (grid %d)\n", hipGetErrorString(e), grid_blocks);
#else
    for (int ph = 0; ph < PH_END; ++ph) {
        p.ph_lo = ph; p.ph_hi = ph + 1;
        hipLaunchKernelGGL(kerns[host_kind_of_phase(ph)], dim3(grid_blocks), dim3(512), kDynLds, stream, p);
    }
#endif
}
```

```cpp
#include <hip/hip_runtime.h>
#include <hip/hip_cooperative_groups.h>
#include <cstdio>
namespace cg = cooperative_groups;

#define DEVI __device__ __forceinline__
typedef unsigned short bf16_t;
typedef short bf16x8 __attribute__((ext_vector_type(8)));
typedef float f32x4 __attribute__((ext_vector_type(4)));
typedef unsigned u32x4 __attribute__((ext_vector_type(4)));
typedef unsigned u32x2 __attribute__((ext_vector_type(2)));

constexpr int D = 2048, T = 8192, TC = 4096, NIN = 6804, NINP = 6912, DFF = 5504, NUP = 11008;
constexpr float ALPHA = 1.4142135623730951f;
constexpr float LOG2E = 1.4426950408889634f;

constexpr size_t O_Y = 0, O_AK = 16777216, O_AV = 23068672, O_BK = 29360128, O_BV = 34603008, O_CC = 39845888, O_CN = 45088768, O_CM = 45129728;

constexpr size_t al256(size_t x) { return (x + 255) & ~(size_t)255; }
constexpr size_t W_CNT = 0;
constexpr size_t W_BAR = 8192;
constexpr size_t W_WIN = 32768;
constexpr size_t W_WOUT = W_WIN + (size_t)2 * NINP * D * 2;
constexpr size_t W_WUP = W_WOUT + (size_t)2 * D * D * 2;
constexpr size_t W_WDN = W_WUP + (size_t)2 * NUP * D * 2;
constexpr size_t W_MODP = W_WDN + (size_t)2 * D * DFF * 2;
constexpr size_t W_MODS = W_MODP + (size_t)2 * 16 * 3 * 12288 * 4;
constexpr size_t W_ROPE = W_MODS + (size_t)2 * 3 * 12288 * 4;
constexpr size_t W_CKA = W_ROPE + 8192;
constexpr size_t W_CVA = W_CKA + (size_t)24 * 65536 * 2;
constexpr size_t W_CKB = W_CVA + (size_t)24 * 65536 * 2;
constexpr size_t W_CVB = W_CKB + (size_t)20 * 65536 * 2;
constexpr size_t W_X = W_CVB + (size_t)20 * 65536 * 2;
constexpr int XS = 2112;
constexpr size_t W_H = W_X + (size_t)T * XS * 4;
constexpr size_t W_R = W_H + (size_t)T * D * 2;
constexpr size_t SZA = (size_t)T * 768 * 2, SZB = (size_t)T * 640 * 2;
constexpr size_t W_QA = W_R, W_KA = W_QA + SZA, W_VAT = W_KA + SZA;
constexpr size_t W_QB = W_VAT + SZA, W_QBR = W_QB + SZB, W_KB = W_QBR + SZB / 2, W_VBT = W_KB + SZB;
constexpr size_t W_QC = W_VBT + SZB, W_KC = W_QC + SZB, W_KCT = W_KC + SZB, W_VCT = W_KCT + SZB, W_OG = W_VCT + SZB;
constexpr size_t W_G = W_OG + SZB;
constexpr size_t W_Y = W_G + (size_t)T * 20 * 4;
constexpr size_t W_ST = W_Y + (size_t)T * D * 2;
constexpr size_t W_SN = W_ST + (size_t)1920 * 16384 * 4;
constexpr size_t W_SS = W_SN + (size_t)1920 * 128 * 4;
constexpr size_t W_REND = W_SS + (size_t)3 * 1920 * 4;
constexpr size_t W_MODP2 = W_R;
constexpr size_t W_U = W_R;
constexpr size_t W_UEND = W_U + (size_t)T * NUP * 2;
constexpr size_t W_ACT = al256(W_REND > W_UEND ? W_REND : W_UEND);
constexpr size_t W_END = W_ACT + (size_t)T * DFF * 2;

struct P {
    const float* in[28];
    float* out;
    char* ws;
    int ph_lo, ph_hi;
};
enum { I_XP = 0, I_XS, I_CAK, I_CAV, I_CBK, I_CBV, I_SC, I_SN, I_SM, I_C, I_CCTX, I_WMOD, I_BMOD, I_WIN, I_GATEB, I_RPB, I_LAMBDA, I_SUBLN, I_CNORM, I_WOUT,
       I_LN1G, I_LN1B, I_LN2G, I_LN2B, I_WUP, I_CONVW, I_CONVB, I_WDN };

DEVI float bf2f(bf16_t v) { return __uint_as_float(((unsigned)v) << 16); }
DEVI float bflo(unsigned u) { return __uint_as_float(u << 16); }
DEVI float bfhi(unsigned u) { return __uint_as_float(u & 0xffff0000u); }
DEVI float wave_sum(float v) {
#pragma unroll
    for (int o = 32; o > 0; o >>= 1) v += __shfl_xor(v, o);
    return v;
}
DEVI float wave_max(float v) {
#pragma unroll
    for (int o = 32; o > 0; o >>= 1) v = fmaxf(v, __shfl_xor(v, o));
    return v;
}
DEVI float sigmoidf_(float x) { return __builtin_amdgcn_rcpf(1.0f + __expf(-x)); }
DEVI float siluf_(float x) { return x * __builtin_amdgcn_rcpf(1.0f + __expf(-x)); }

DEVI int TIDX() { int t = threadIdx.x; asm volatile("" : "+v"(t)); return t; }
DEVI int BIDX() { int b = blockIdx.x; asm volatile("" : "+s"(b)); return b; }
DEVI char* WSP(char* w) { asm volatile("" : "+s"(w)); return w; }
#define ONE_LAUNCH 1
namespace pg8 {
#define PG8_LAS __attribute__((address_space(3)))
typedef unsigned short bf16_t;
typedef short bf16x8 __attribute__((ext_vector_type(8)));
typedef float f32x4 __attribute__((ext_vector_type(4)));
typedef unsigned u32x4 __attribute__((ext_vector_type(4)));
constexpr int BM = 256, BK = 64, HALF = 128, HTB = HALF * BK * 2  , STAGE_BYTES = 8 * HTB, NXCD = 8, WGM = 8;

__host__ __device__ __forceinline__ int lds_byte(int r, int c) { const int st = (r >> 4) * 2 + (c >> 5), rr = r & 15, cc = c & 31, ob = rr * 64 + cc * 2; return st * 1024 + (ob ^ (((ob >> 9) & 1) << 5)); }
__host__ __device__ __forceinline__ void stage_rc(int b, int& R, int& C) { const int st = b / 1024, sb = b % 1024, swz = sb ^ (((sb >> 9) & 1) << 5); R = (st >> 1) * 16 + swz / 64; C = (st & 1) * 32 + (swz % 64) / 2; }
__host__ __device__ __forceinline__ int perm32(int rho) { const int n = rho >> 4, i = rho & 15; return 8 * (i >> 2) + 4 * n + (i & 3); }

struct Unit { int pm, pn; };
struct Gemm { const bf16_t* A; const bf16_t* Bt; int M, N, K; };

struct StaticOrder {
    int nM, nN, nwg, G, c;
    __host__ __device__ __forceinline__ void init(int M, int N, int G_, int c_) { nM = M / BM; nN = N / BM; nwg = nM * nN; G = G_; c = c_; }
    __host__ __device__ __forceinline__ bool next(int i, Unit& u) const {
        const long L = (long)i * G + c; if (L >= nwg) return false;
        int wgid = (int)L; { const int q = nwg / NXCD, r = nwg % NXCD, xcd = wgid % NXCD, off = wgid / NXCD; wgid = (xcd < r ? xcd * (q + 1) : r * (q + 1) + (xcd - r) * q) + off; }
        const int nig = WGM * nN, gid = wgid / nig, fm = gid * WGM, gsz = (nM - fm) < WGM ? (nM - fm) : WGM;
        u.pm = fm + ((wgid % nig) % gsz); u.pn = (wgid % nig) / gsz; return true;
    }
    __device__ __forceinline__ void a_ready(const Unit&) const {}
    __device__ __forceinline__ void done(const Unit&) const {}
};
__device__ __forceinline__ unsigned cvt_pk_bf16(float lo, float hi) { unsigned r; asm volatile("v_cvt_pk_bf16_f32 %0, %1, %2" : "=v"(r) : "v"(lo), "v"(hi)); return r; }
template <class Epi, class Sched>
__device__ __forceinline__ void gemm_phase(PG8_LAS unsigned char* lds, const Gemm g, const Sched& S, const Epi& E) {
    const int tid = TIDX(), wid = __builtin_amdgcn_readfirstlane(tid >> 6), lane = tid & 63, wr = wid >> 2, wc = wid & 3, fr = lane & 15, fq = lane >> 4;
    const int K = g.K, nt = K / BK;
    unsigned voffA[2], voffB[2];
#pragma unroll
    for (int i = 0; i < 2; ++i) { int R, C; stage_rc(tid * 16 + i * 8192, R, C); const int Rb = Epi::PERM ? ((R & ~31) + perm32(R & 31)) : R;
        voffA[i] = (unsigned)(R * K + C) * 2u; voffB[i] = (unsigned)(Rb * K + C) * 2u; }
    const size_t kstep = (size_t)(BK * 2);
    const size_t hstep = (size_t)HALF * K * 2;
    const size_t tstep = 2 * hstep;
    const unsigned ldsw = (unsigned)wid * 1024u;
    const int aoff = lds_byte(wr * 64 + fr, fq * 8), boff = lds_byte(wc * 32 + fr, fq * 8);
#define PG8_SA(b, h) (((b) * 2 + (h)) * HTB)
#define PG8_SB(b, h) ((4 + (b) * 2 + (h)) * HTB)
#define PG8_STAGE(bufoff, gbase, voff) do { _Pragma("unroll") for (int _i = 0; _i < 2; ++_i) \
        __builtin_amdgcn_global_load_lds((const unsigned*)((const char*)(gbase) + (voff)[_i]), (PG8_LAS unsigned*)(lds + (bufoff) + ldsw + _i * 8192), 16, 0, 0); } while (0)
#define PG8_LDA(dst, b, h) do { _Pragma("unroll") for (int m = 0; m < 4; ++m) _Pragma("unroll") for (int k = 0; k < 2; ++k) dst[m][k] = *(const PG8_LAS bf16x8*)(lds + PG8_SA(b, h) + aoff + m * 2048 + k * 1024); } while (0)
#define PG8_LDB(dst, b, h) do { _Pragma("unroll") for (int n = 0; n < 2; ++n) _Pragma("unroll") for (int k = 0; k < 2; ++k) dst[n][k] = *(const PG8_LAS bf16x8*)(lds + PG8_SB(b, h) + boff + n * 2048 + k * 1024); } while (0)
#define PG8_MMA(ai, bj, At, Bt) do { __builtin_amdgcn_s_setprio(1); _Pragma("unroll") for (int m = 0; m < 4; ++m) _Pragma("unroll") for (int n = 0; n < 2; ++n) _Pragma("unroll") for (int k = 0; k < 2; ++k) \
        acc[ai][bj][m][n] = __builtin_amdgcn_mfma_f32_16x16x32_bf16(Bt[n][k], At[m][k], acc[ai][bj][m][n], 0, 0, 0); __builtin_amdgcn_s_setprio(0); } while (0)
#define PG8_WAIT_V(n) asm volatile("s_waitcnt vmcnt(" #n ")" ::: "memory")
#define PG8_WAIT_L(n) asm volatile("s_waitcnt lgkmcnt(" #n ")" ::: "memory")
#define PG8_BAR __builtin_amdgcn_s_barrier()
#define PG8_SCHED __builtin_amdgcn_sched_barrier(0)
    Unit cur, nxt; int ui = 0;
    if (!S.next(0, cur)) return;
    f32x4 acc[2][2][4][2];
#pragma unroll
    for (int a = 0; a < 2; ++a)
#pragma unroll
        for (int b = 0; b < 2; ++b)
#pragma unroll
            for (int m = 0; m < 4; ++m)
#pragma unroll
                for (int n = 0; n < 2; ++n) acc[a][b][m][n] = (f32x4){0.f, 0.f, 0.f, 0.f};
    bf16x8 At[4][2], B0[2][2], B1[2][2];
    const char* cA = (const char*)g.A + (size_t)cur.pm * tstep; const char* cB = (const char*)g.Bt + (size_t)cur.pn * tstep;
    S.a_ready(cur);
    PG8_STAGE(PG8_SB(0, 0), cB, voffB); PG8_STAGE(PG8_SA(0, 0), cA, voffA); PG8_STAGE(PG8_SB(0, 1), cB + hstep, voffB); PG8_STAGE(PG8_SA(0, 1), cA + hstep, voffA);
    if (wr == 1) PG8_BAR;
    PG8_WAIT_V(4); PG8_BAR;
    PG8_STAGE(PG8_SB(1, 0), cB + kstep, voffB); PG8_STAGE(PG8_SA(1, 0), cA + kstep, voffA); PG8_STAGE(PG8_SB(1, 1), cB + hstep + kstep, voffB);
    PG8_WAIT_V(6); PG8_BAR;
    for (;;) {
        const bool has_next = S.next(ui + 1, nxt);
        const char* nA = has_next ? (const char*)g.A + (size_t)nxt.pm * tstep : cA; const char* nB = has_next ? (const char*)g.Bt + (size_t)nxt.pn * tstep : cB;
        for (int t = 0; t < nt; t += 2) {
            const bool last = (t == nt - 2);
            const char* a1 = cA + (size_t)(t + 1) * kstep;
            const char* a2 = last ? nA : cA + (size_t)(t + 2) * kstep; const char* b2 = last ? nB : cB + (size_t)(t + 2) * kstep;
            const char* a3 = a2 + kstep; const char* b3 = b2 + kstep;
            if (last && has_next) S.a_ready(nxt);
            PG8_LDB(B0, 0, 0); PG8_SCHED; PG8_LDA(At, 0, 0); PG8_STAGE(PG8_SA(1, 1), a1 + hstep, voffA);
            PG8_WAIT_L(8); PG8_BAR; PG8_WAIT_L(0); PG8_MMA(0, 0, At, B0); PG8_BAR; PG8_SCHED;
            PG8_LDB(B1, 0, 1); PG8_STAGE(PG8_SB(0, 0), b2, voffB);
            PG8_BAR; PG8_WAIT_L(0); PG8_MMA(0, 1, At, B1); PG8_BAR;
            PG8_LDA(At, 0, 1); PG8_STAGE(PG8_SA(0, 0), a2, voffA);
            PG8_BAR; PG8_WAIT_L(0); PG8_MMA(1, 0, At, B0); PG8_BAR; PG8_SCHED;
            PG8_STAGE(PG8_SB(0, 1), b2 + hstep, voffB);
            PG8_WAIT_V(6); PG8_BAR; PG8_MMA(1, 1, At, B1); PG8_BAR;
            PG8_LDB(B0, 1, 0); PG8_SCHED; PG8_LDA(At, 1, 0); PG8_STAGE(PG8_SA(0, 1), a2 + hstep, voffA);
            PG8_WAIT_L(8); PG8_BAR; PG8_WAIT_L(0); PG8_MMA(0, 0, At, B0); PG8_BAR; PG8_SCHED;
            PG8_LDB(B1, 1, 1); PG8_STAGE(PG8_SB(1, 0), b3, voffB);
            PG8_BAR; PG8_WAIT_L(0); PG8_MMA(0, 1, At, B1); PG8_BAR;
            PG8_LDA(At, 1, 1); PG8_STAGE(PG8_SA(1, 0), a3, voffA);
            PG8_BAR; PG8_WAIT_L(0); PG8_MMA(1, 0, At, B0); PG8_BAR; PG8_SCHED;
            PG8_STAGE(PG8_SB(1, 1), b3 + hstep, voffB);
            PG8_WAIT_V(6); PG8_BAR; PG8_MMA(1, 1, At, B1); PG8_BAR;
        }
        if constexpr (!Epi::AFTER_DRAIN) { E(acc, cur, wr, wc, fr, fq); S.done(cur); }
        if (!has_next) break;
#pragma unroll
        for (int a = 0; a < 2; ++a)
#pragma unroll
            for (int b = 0; b < 2; ++b)
#pragma unroll
                for (int m = 0; m < 4; ++m)
#pragma unroll
                    for (int n = 0; n < 2; ++n) acc[a][b][m][n] = (f32x4){0.f, 0.f, 0.f, 0.f};
        cur = nxt; cA = nA; cB = nB; ++ui;
    }
    PG8_WAIT_V(0);
    if (wr == 0) PG8_BAR;
    PG8_BAR;
    if constexpr (Epi::AFTER_DRAIN) { E.fused(acc, cur, wr, wc, fr, fq, lds, wid, lane); S.done(cur); }
#undef PG8_SA
#undef PG8_SB
#undef PG8_STAGE
#undef PG8_LDA
#undef PG8_LDB
#undef PG8_MMA
#undef PG8_WAIT_V
#undef PG8_WAIT_L
#undef PG8_BAR
#undef PG8_SCHED
}
}

using pg8::cvt_pk_bf16;
DEVI bf16x8 ld8(const bf16_t* p) { return *(const bf16x8*)p; }
DEVI bf16x8 ld4x2(const bf16_t* p0, const bf16_t* p1) {
    const u32x2 a = *(const u32x2*)p0, b = *(const u32x2*)p1;
    const u32x4 r = {a[0], a[1], b[0], b[1]};
    return __builtin_bit_cast(bf16x8, r);
}
DEVI bf16x8 pack8(f32x4 a, f32x4 b) {
    const u32x4 r = {cvt_pk_bf16(a[0], a[1]), cvt_pk_bf16(a[2], a[3]), cvt_pk_bf16(b[0], b[1]), cvt_pk_bf16(b[2], b[3])};
    return __builtin_bit_cast(bf16x8, r);
}
DEVI void st4(bf16_t* p, f32x4 v) { const u32x2 r = {cvt_pk_bf16(v[0], v[1]), cvt_pk_bf16(v[2], v[3])}; *(u32x2*)p = r; }
DEVI bf16_t f2bf1(float f) { return (bf16_t)(cvt_pk_bf16(f, 0.f) & 0xffffu); }
DEVI f32x4 mfma16(bf16x8 a, bf16x8 b, f32x4 c) { return __builtin_amdgcn_mfma_f32_16x16x32_bf16(a, b, c, 0, 0, 0); }
DEVI float ex2(float x) { return __builtin_amdgcn_exp2f(x); }
DEVI int clampi(int v, int lo, int hi) { return v < lo ? lo : (v > hi ? hi : v); }
DEVI int cond_of_row(int t) { return t < TC ? 0 : 1 + ((t - TC) >> 11); }

DEVI void transpose_tile(const float* __restrict__ W, bf16_t* __restrict__ Wt, int K, int N, int tk, int tn, float* sm) {
    const int tid = TIDX();
#pragma unroll
    for (int p = 0; p < 2; ++p) {
        const int kr = p * 32 + (tid >> 4), nc = (tid & 15) * 4;
        const int gk = tk * 64 + kr, gn = tn * 64 + nc;
        f32x4 v = {0.f, 0.f, 0.f, 0.f};
        if (gn < N) v = *(const f32x4*)(W + (size_t)gk * N + gn);
        sm[kr * 65 + nc + 0] = v[0]; sm[kr * 65 + nc + 1] = v[1]; sm[kr * 65 + nc + 2] = v[2]; sm[kr * 65 + nc + 3] = v[3];
    }
    __syncthreads();
    const int n = tid >> 3, kg = tid & 7;
    float f[8];
#pragma unroll
    for (int j = 0; j < 8; ++j) f[j] = sm[(kg * 8 + j) * 65 + n];
    const u32x4 o = {cvt_pk_bf16(f[0], f[1]), cvt_pk_bf16(f[2], f[3]), cvt_pk_bf16(f[4], f[5]), cvt_pk_bf16(f[6], f[7])};
    *(u32x4*)(Wt + (size_t)(tn * 64 + n) * K + tk * 64 + kg * 8) = o;
    __syncthreads();
}
DEVI void conv_T(const float* W, bf16_t* Wt, int K, int N, int Npad, int nmat, int rot, float* sm) {
    const int tkn = K / 64, tnn = Npad / 64, per = tkn * tnn, total = per * nmat;
    const int start = (int)((BIDX() + gridDim.x - (rot % gridDim.x)) % gridDim.x);
    for (int t = start; t < total; t += gridDim.x) {
        const int mat = t / per, r = t % per, tk = r / tnn, tn = r % tnn;
        transpose_tile(W + (size_t)mat * K * N, Wt + (size_t)mat * Npad * K, K, N, tk, tn, sm);
    }
}
DEVI void conv_T2_unit(const float* __restrict__ W, bf16_t* __restrict__ Wt, int K, int N, int Npad, int u, int tid) {
    const int nbn = (Npad + 2047) / 2048;
    const int kb = u / nbn, nb = u % nbn;
    const int n = nb * 2048 + tid * 4;
    if (n >= Npad) return;
    f32x4 r[16];
    const float* src = W + (size_t)(kb * 16) * N + n;
#pragma unroll
    for (int j = 0; j < 16; ++j) r[j] = n < N ? __builtin_nontemporal_load((const f32x4*)(src + (size_t)j * N)) : (f32x4){0.f, 0.f, 0.f, 0.f};
#pragma unroll
    for (int i = 0; i < 4; ++i) {
        const u32x4 lo = {cvt_pk_bf16(r[0][i], r[1][i]), cvt_pk_bf16(r[2][i], r[3][i]), cvt_pk_bf16(r[4][i], r[5][i]), cvt_pk_bf16(r[6][i], r[7][i])};
        const u32x4 hi = {cvt_pk_bf16(r[8][i], r[9][i]), cvt_pk_bf16(r[10][i], r[11][i]), cvt_pk_bf16(r[12][i], r[13][i]), cvt_pk_bf16(r[14][i], r[15][i])};
        bf16_t* d = Wt + (size_t)(n + i) * K + kb * 16;
        *(u32x4*)d = lo; *(u32x4*)(d + 8) = hi;
    }
}
DEVI void conv_T3_unit(const float* __restrict__ W, bf16_t* __restrict__ Wt, int K, int N, int tn, int tk0, int ntk, int rot, float* sm, int tid) {
    const int kr = tid >> 4, nc = (tid & 15) * 4, gn = tn * 64 + nc;
    const int n = tid >> 3, kg = tid & 7;
    const bool inb = gn < N;
    f32x4 v0 = {0.f, 0.f, 0.f, 0.f}, v1 = v0;
    { const int tk = tk0 + (rot % ntk);
      if (inb) { v0 = __builtin_nontemporal_load((const f32x4*)(W + (size_t)(tk * 64 + kr) * N + gn)); v1 = __builtin_nontemporal_load((const f32x4*)(W + (size_t)(tk * 64 + 32 + kr) * N + gn)); } }
    for (int i = 0; i < ntk; ++i) {
        const int tk = tk0 + ((rot + i) % ntk);
        sm[kr * 65 + nc + 0] = v0[0]; sm[kr * 65 + nc + 1] = v0[1]; sm[kr * 65 + nc + 2] = v0[2]; sm[kr * 65 + nc + 3] = v0[3];
        sm[(32 + kr) * 65 + nc + 0] = v1[0]; sm[(32 + kr) * 65 + nc + 1] = v1[1]; sm[(32 + kr) * 65 + nc + 2] = v1[2]; sm[(32 + kr) * 65 + nc + 3] = v1[3];
        if (i + 1 < ntk && inb) {
            const int tk2 = tk0 + ((rot + i + 1) % ntk);
            v0 = __builtin_nontemporal_load((const f32x4*)(W + (size_t)(tk2 * 64 + kr) * N + gn)); v1 = __builtin_nontemporal_load((const f32x4*)(W + (size_t)(tk2 * 64 + 32 + kr) * N + gn));
        }
        __syncthreads();
        float f[8];
#pragma unroll
        for (int j = 0; j < 8; ++j) f[j] = sm[(kg * 8 + j) * 65 + n];
        const u32x4 o = {cvt_pk_bf16(f[0], f[1]), cvt_pk_bf16(f[2], f[3]), cvt_pk_bf16(f[4], f[5]), cvt_pk_bf16(f[6], f[7])};
        *(u32x4*)(Wt + (size_t)(tn * 64 + n) * K + tk * 64 + kg * 8) = o;
        __syncthreads();
    }
}
DEVI void conv_plain(const float* __restrict__ src, bf16_t* __restrict__ dst, size_t n4) {
    const size_t nthr = (size_t)gridDim.x * 512;
    for (size_t i0 = (size_t)BIDX() * 512 + TIDX(); i0 < n4; i0 += 4 * nthr) {
        f32x4 v[4];
#pragma unroll
        for (int u = 0; u < 4; ++u) { const size_t i = i0 + u * nthr; if (i < n4) v[u] = __builtin_nontemporal_load((const f32x4*)(src + i * 4)); }
#pragma unroll
        for (int u = 0; u < 4; ++u) { const size_t i = i0 + u * nthr; if (i < n4) st4(dst + i * 4, v[u]); }
    }
}
DEVI void weight_units(const P& p, int l, int u0, int u1, int w, int nw, float* sm) {
    const int tid = TIDX();
    char* ws = WSP(p.ws);
    const int rot = w & 15;
    for (int u = u0 + w; u < u1; u += nw) {
        int v = u;
        if (v < 216) conv_T3_unit(p.in[I_WIN] + (size_t)l * D * NIN, (bf16_t*)(ws + W_WIN) + (size_t)l * NINP * D, D, NIN, v >> 1, (v & 1) * 16, 16, rot, sm, tid);
        else if ((v -= 216) < 64) conv_T3_unit(p.in[I_WOUT] + (size_t)l * D * D, (bf16_t*)(ws + W_WOUT) + (size_t)l * D * D, D, D, v >> 1, (v & 1) * 16, 16, rot, sm, tid);
        else if ((v -= 64) < 344) conv_T3_unit(p.in[I_WUP] + (size_t)l * D * NUP, (bf16_t*)(ws + W_WUP) + (size_t)l * NUP * D, D, NUP, v >> 1, (v & 1) * 16, 16, rot, sm, tid);
        else { v -= 344; const int part = v % 6; conv_T3_unit(p.in[I_WDN] + (size_t)l * DFF * D, (bf16_t*)(ws + W_WDN) + (size_t)l * D * DFF, DFF, D, v / 6, part * 16, part == 5 ? 6 : 16, rot, sm, tid); }
    }
}
DEVI void phase0a(const P& p, float* sm) {
    const int tid = TIDX();
    char* ws = WSP(p.ws);
    for (int it = BIDX(); it < 768; it += gridDim.x) {
        const int l = it / 384, kc = (it % 384) / 6, jb = it % 6;
        if (tid < 96) { const int ci = tid >> 5, k = kc * 32 + (tid & 31); const float cv = ci == 0 ? p.in[I_CCTX][k] : p.in[I_C][(ci - 1) * D + k]; sm[tid] = siluf_(cv); }
        __syncthreads();
        const int j = jb * 2048 + tid * 4;
        f32x4 a0 = {0.f, 0.f, 0.f, 0.f}, a1 = a0, a2 = a0;
        const float* wp = p.in[I_WMOD] + ((size_t)l * D + kc * 32) * 12288 + j;
#pragma unroll
        for (int h2 = 0; h2 < 2; ++h2) {
            f32x4 w[16];
#pragma unroll
            for (int kk = 0; kk < 16; ++kk) w[kk] = __builtin_nontemporal_load((const f32x4*)(wp + (size_t)(h2 * 16 + kk) * 12288));
#pragma unroll
            for (int kk = 0; kk < 16; ++kk) { a0 += sm[h2 * 16 + kk] * w[kk]; a1 += sm[32 + h2 * 16 + kk] * w[kk]; a2 += sm[64 + h2 * 16 + kk] * w[kk]; }
        }
        float* mp = (float*)(ws + W_MODP2) + ((size_t)(l * 64 + kc) * 3) * 12288 + j;
        *(f32x4*)(mp) = a0; *(f32x4*)(mp + 12288) = a1; *(f32x4*)(mp + 2 * 12288) = a2;
        __syncthreads();
    }
#if PROBE
    if (blockIdx.x == 0 && threadIdx.x == 0) ((unsigned long long*)(p.ws + W_CNT + 2048))[45] = wall_clock64();
#endif
    if (BIDX() == gridDim.x - 1) {
        float* rt = (float*)(ws + W_ROPE);
        for (int i = tid; i < 1024; i += 512) {
            const int pos = i >> 4, fi = i & 15;
            const float freq = __expf(-(float)fi * 0.5756462732485115f);
            const float ang = (float)pos * freq;
            rt[i] = __cosf(ang); rt[1024 + i] = __sinf(ang);
        }
    }
    weight_units(p, 0, 0, 280, BIDX(), (int)gridDim.x, sm);
    conv_T(p.in[I_CAV], (bf16_t*)(ws + W_CVA), 512, 128, 128, 24, 100, sm);
    conv_T(p.in[I_CBV], (bf16_t*)(ws + W_CVB), 512, 128, 128, 20, 200, sm);
    conv_plain(p.in[I_CAK], (bf16_t*)(ws + W_CKA), (size_t)24 * 65536 / 4);
    conv_plain(p.in[I_CBK], (bf16_t*)(ws + W_CKB), (size_t)20 * 65536 / 4);
}
DEVI void phase0b(const P& p) {
    const float* mp = (const float*)(WSP(p.ws) + W_MODP2);
    float* mo = (float*)(WSP(p.ws) + W_MODS);
    for (int i = BIDX() * 512 + TIDX(); i < 2 * 3 * 12288; i += gridDim.x * 512) {
        const int l = i / 36864, r = i % 36864, ci = r / 12288, j = r % 12288;
        float s = p.in[I_BMOD][l * 12288 + j];
        float s2 = 0.f, s3 = 0.f, s4 = 0.f;
#pragma unroll 4
        for (int kc = 0; kc < 64; kc += 4) {
            s += mp[((size_t)(l * 64 + kc) * 3 + ci) * 12288 + j]; s2 += mp[((size_t)(l * 64 + kc + 1) * 3 + ci) * 12288 + j];
            s3 += mp[((size_t)(l * 64 + kc + 2) * 3 + ci) * 12288 + j]; s4 += mp[((size_t)(l * 64 + kc + 3) * 3 + ci) * 12288 + j];
        }
        s += s2 + s3 + s4;
        mo[i] = s;
    }
}
DEVI void phase0c(const P& p) {
    const float* __restrict__ mods = (const float*)(WSP(p.ws) + W_MODS);
    bf16_t* __restrict__ H = (bf16_t*)(WSP(p.ws) + W_H);
    const float* __restrict__ xp = p.in[I_XP]; const float* __restrict__ xs = p.in[I_XS];
    const int nthr = gridDim.x * 512;
    for (int i0 = BIDX() * 512 + TIDX(); i0 < T * 512; i0 += 4 * nthr) {
        f32x4 x[4], sh[4], sc[4];
#pragma unroll
        for (int u = 0; u < 4; ++u) {
            const int i = i0 + u * nthr;
            if (i < T * 512) {
                const int t = i >> 9, c = (i & 511) * 4;
                const float* xr = t < TC ? xp + (size_t)t * D : xs + (size_t)(t - TC) * D;
                const float* mr = mods + (size_t)cond_of_row(t) * 12288;
                x[u] = *(const f32x4*)(xr + c); sh[u] = *(const f32x4*)(mr + c); sc[u] = *(const f32x4*)(mr + 2048 + c);
            }
        }
#pragma unroll
        for (int u = 0; u < 4; ++u) {
            const int i = i0 + u * nthr;
            if (i < T * 512) { const int t = i >> 9, c = (i & 511) * 4; st4(H + (size_t)t * D + c, x[u] * (1.0f + sc[u]) + sh[u]); }
        }
    }
}

struct EpiIn {
    static constexpr bool PERM = false, AFTER_DRAIN = false;
    char* ws; float* out; const float* gate_b; int l;
    DEVI void operator()(const f32x4 (&acc)[2][2][4][2], const pg8::Unit& u, int wr, int wc, int fr, int fq) const {
        asm volatile("" : "+v"(fr), "+v"(fq), "+s"(wr), "+s"(wc));
        const bool ctx = u.pm < 16;
        const int b = ctx ? u.pm : ((u.pm - 16) >> 3);
        const int sbase = (ctx ? 0 : ((u.pm - 16) & 7) * 256) + wr * 64 + fr;
        const int rbase = u.pm * 256 + wr * 64 + fr;
        const int S = ctx ? 256 : 2048;
        const int dc = wc * 32 + fq * 4;
        const float* rope = (const float*)(ws + W_ROPE);
        const int lay = l;
        half<0>(acc, u, wr, wc, fr, fq, ctx, b, sbase, rbase, S, dc, rope, lay);
        half<1>(acc, u, wr, wc, fr, fq, ctx, b, sbase, rbase, S, dc, rope, lay);
    }
    template <int bj>
    DEVI void half(const f32x4 (&acc)[2][2][4][2], const pg8::Unit& u, int wr, int wc, int fr, int fq, bool ctx, int b, int sbase, int rbase, int S, int dc, const float* rope, int lay) const {
        {
            const int cgi = 2 * u.pn + bj;
            if (cgi >= 54) return;
            auto each = [&](auto f) __attribute__((always_inline)) {
#pragma unroll
                for (int ai = 0; ai < 2; ++ai)
#pragma unroll
                    for (int m = 0; m < 4; ++m)
#pragma unroll
                        for (int n = 0; n < 2; ++n) f(acc[ai][bj][m][n], rbase + 128 * ai + 16 * m, sbase + 128 * ai + 16 * m, n);
            };
            auto tokmaj = [&](bf16_t* base, int stride, int head, float mul) __attribute__((always_inline)) {
                each([&](f32x4 v, int r, int s, int n) __attribute__((always_inline)) { st4(base + (size_t)r * stride + head * 128 + dc + 16 * n, v * mul); });
            };
            auto transp = [&](bf16_t* base, int Hn, int head) __attribute__((always_inline)) {
                bf16_t* bb = base + (ctx ? (size_t)0 : (size_t)16 * Hn * 32768) + (size_t)(b * Hn + head) * 128 * S;
                each([&](f32x4 v, int r, int s, int n) __attribute__((always_inline)) {
                    const unsigned A = cvt_pk_bf16(v[0], v[1]), B = cvt_pk_bf16(v[2], v[3]);
                    const bool odd = (fr & 1) != 0;
                    const unsigned recv = (unsigned)__builtin_amdgcn_mov_dpp((int)(odd ? A : B), 0xB1, 0xF, 0xF, true);
                    const unsigned w0 = odd ? ((recv & 0xffffu) | (B << 16)) : ((A & 0xffffu) | (recv << 16));
                    const unsigned w1 = odd ? ((recv >> 16) | (B & 0xffff0000u)) : ((A >> 16) | (recv & 0xffff0000u));
                    const int dd = dc + 16 * n + (odd ? 2 : 0), s2 = odd ? s - 1 : s;
                    *(unsigned*)(bb + (size_t)dd * S + s2) = w0;
                    *(unsigned*)(bb + (size_t)(dd + 1) * S + s2) = w1;
                });
            };
            auto outf = [&](float* obase, int Hn, int head) __attribute__((always_inline)) {
                float* ob = obase + (size_t)((b * 2 + lay) * Hn + head) * 32768;
                each([&](f32x4 v, int r, int s, int n) __attribute__((always_inline)) { *(f32x4*)(ob + (size_t)s * 128 + dc + 16 * n) = v; });
            };
            if (cgi < 6) {
                tokmaj((bf16_t*)(ws + W_QA), 768, cgi, 1.0f);
            } else if (cgi < 12) {
                tokmaj((bf16_t*)(ws + W_KA), 768, cgi - 6, 1.0f);
                if (ctx) outf(out + O_AK, 6, cgi - 6);
            } else if (cgi < 18) {
                transp((bf16_t*)(ws + W_VAT), 6, cgi - 12);
                if (ctx) outf(out + O_AV, 6, cgi - 12);
            } else if (cgi < 28) {
                const bool isq = cgi < 23;
                const int head = isq ? cgi - 18 : cgi - 23;
                if (isq || ctx) tokmaj((bf16_t*)(ws + (isq ? W_QB : W_KB)), 640, head, 1.0f);
                if (!isq && ctx) outf(out + O_BK, 5, head);
                if (!ctx) {
                    bf16_t* rb = isq ? (bf16_t*)(ws + W_QBR) + (size_t)(rbase - TC) * 640 : (bf16_t*)(ws + W_KB) + (size_t)rbase * 640;
#pragma unroll
                    for (int ai = 0; ai < 2; ++ai)
#pragma unroll
                        for (int m = 0; m < 4; ++m) {
                            const int s = sbase + 128 * ai + 16 * m;
                            const int pos = (wc & 1) ? (s & 63) : (s >> 6);
                            const f32x4 cs = *(const f32x4*)(rope + pos * 16 + 4 * fq), sn = *(const f32x4*)(rope + 1024 + pos * 16 + 4 * fq);
                            const f32x4 x1 = acc[ai][bj][m][0], x2 = acc[ai][bj][m][1];
                            bf16_t* d = rb + (size_t)(128 * ai + 16 * m) * 640 + head * 128 + dc;
                            st4(d, x1 * cs - x2 * sn);
                            st4(d + 16, x1 * sn + x2 * cs);
                        }
                }
            } else if (cgi < 33) {
                transp((bf16_t*)(ws + W_VBT), 5, cgi - 28);
                if (ctx) outf(out + O_BV, 5, cgi - 28);
            } else if (cgi < 38) {
                tokmaj((bf16_t*)(ws + W_QC), 640, cgi - 33, 0.08838834764831845f);
            } else if (cgi < 43) {
                tokmaj((bf16_t*)(ws + W_KC), 640, cgi - 38, 1.0f);
                transp((bf16_t*)(ws + W_KCT), 5, cgi - 38);
            } else if (cgi < 48) {
                transp((bf16_t*)(ws + W_VCT), 5, cgi - 43);
            } else if (cgi < 53) {
                bf16_t* base = (bf16_t*)(ws + W_OG);
                const int head = cgi - 48;
                each([&](f32x4 v, int r, int s, int n) __attribute__((always_inline)) {
                    f32x4 o;
#pragma unroll
                    for (int i = 0; i < 4; ++i) o[i] = sigmoidf_(v[i]);
                    st4(base + (size_t)r * 640 + head * 128 + dc + 16 * n, o);
                });
            } else {
                if (wc == 0) {
                    float* G = (float*)(ws + W_G);
                    each([&](f32x4 v, int r, int s, int n) __attribute__((always_inline)) {
                        if (n == 0 || fq == 0) {
#pragma unroll
                            for (int i = 0; i < 4; ++i) {
                                const int col = 16 * n + 4 * fq + i;
                                float x = v[i] + gate_b[lay * 20 + col];
                                if ((col / 5) & 1) { const float ee = __expf(-fabsf(x)), uu = 1.0f + ee, dd = uu - 1.0f; x = fminf(x, 0.f) - (dd == 0.f ? ee : __logf(uu) * (ee / dd)); }
                                G[(size_t)r * 20 + col] = x;
                            }
                        }
                    });
                }
            }
        }
    }
};
struct EpiRes {
    static constexpr bool PERM = false, AFTER_DRAIN = false;
    const float* xin_c; const float* xin_l; float* X; const float* gate;
    DEVI void operator()(const f32x4 (&acc)[2][2][4][2], const pg8::Unit& u, int wr, int wc, int fr, int fq) const {
        asm volatile("" : "+v"(fr), "+v"(fq), "+s"(wr), "+s"(wc));
        const int row0 = u.pm * 256 + wr * 64 + fr, col0 = u.pn * 256 + wc * 32 + 4 * fq;
        const float* gr = gate + (size_t)(u.pm < 16 ? 0 : 1 + ((u.pm - 16) >> 3)) * 12288;
        f32x4 gv[2][2];
#pragma unroll
        for (int bj = 0; bj < 2; ++bj)
#pragma unroll
            for (int n = 0; n < 2; ++n) gv[bj][n] = *(const f32x4*)(gr + col0 + bj * 128 + n * 16);
#pragma unroll
        for (int ai = 0; ai < 2; ++ai)
#pragma unroll
            for (int m = 0; m < 4; ++m) {
                const int r = row0 + ai * 128 + m * 16;
                const float* xr = (r < TC ? xin_c + (size_t)r * D : xin_l + (size_t)(r - TC) * D) + col0;
                float* xo = X + (size_t)r * D + col0;
#pragma unroll
                for (int bj = 0; bj < 2; ++bj)
#pragma unroll
                    for (int n = 0; n < 2; ++n) {
                        const f32x4 xv = *(const f32x4*)(xr + bj * 128 + n * 16);
                        *(f32x4*)(xo + bj * 128 + n * 16) = ALPHA * xv + gv[bj][n] * acc[ai][bj][m][n];
                    }
            }
    }
};
struct EpiResLN {
    static constexpr bool PERM = true, AFTER_DRAIN = true;
    const float* xin_c; const float* xin_l; float* xout; const float* gate; const float* gam; const float* bet; const float* hmods; bf16_t* H; float* stats; unsigned* cnt; int xs_in, xs_out;
    DEVI void operator()(const f32x4 (&)[2][2][4][2], const pg8::Unit&, int, int, int, int) const {}
    DEVI void fused(f32x4 (&acc)[2][2][4][2], const pg8::Unit& u, int wr, int wc, int fr, int fq, PG8_LAS unsigned char* lds, int wid, int lane) const {
        asm volatile("" : "+v"(fr), "+v"(fq), "+s"(wr), "+s"(wc));
        const int tid = wid * 64 + lane;
        const int cond = u.pm < 16 ? 0 : 1 + ((u.pm - 16) >> 3);
        const int row0 = u.pm * 256 + wr * 64 + fr, col0 = u.pn * 256 + wc * 32 + 8 * fq;
        {
            const float* gr = gate + (size_t)cond * 12288 + col0;
            f32x4 gv[2][2];
#pragma unroll
            for (int bj = 0; bj < 2; ++bj)
#pragma unroll
                for (int n = 0; n < 2; ++n) gv[bj][n] = *(const f32x4*)(gr + bj * 128 + n * 4);
#pragma unroll
            for (int ai = 0; ai < 2; ++ai)
#pragma unroll
                for (int m = 0; m < 4; ++m) {
                    const int r = row0 + ai * 128 + m * 16;
                    const float* xr = (r < TC ? xin_c + (size_t)r * xs_in : xin_l + (size_t)(r - TC) * xs_in) + col0;
#pragma unroll
                    for (int bj = 0; bj < 2; ++bj)
#pragma unroll
                        for (int n = 0; n < 2; ++n) acc[ai][bj][m][n] = ALPHA * *(const f32x4*)(xr + bj * 128 + n * 4) + gv[bj][n] * acc[ai][bj][m][n];
                }
        }
        PG8_LAS float* red = (PG8_LAS float*)lds;
        PG8_LAS float* mr = (PG8_LAS float*)(lds + 32768);
#pragma unroll
        for (int ai = 0; ai < 2; ++ai)
#pragma unroll
            for (int m = 0; m < 4; ++m) {
                float sv = 0.f, qv = 0.f;
#pragma unroll
                for (int bj = 0; bj < 2; ++bj)
#pragma unroll
                    for (int n = 0; n < 2; ++n) {
                        const f32x4 z = acc[ai][bj][m][n];
                        sv += z[0] + z[1] + z[2] + z[3];
                        qv += z[0] * z[0] + z[1] * z[1] + z[2] * z[2] + z[3] * z[3];
                    }
                { const int rl = ai * 128 + wr * 64 + m * 16 + fr; red[(rl * 16 + wc * 4 + fq) * 2] = sv; red[(rl * 16 + wc * 4 + fq) * 2 + 1] = qv; }
            }
        __syncthreads();
        float* st = stats + ((size_t)u.pm * 256) * 16;
        if (tid < 256) {
            float sv = 0.f, qv = 0.f;
#pragma unroll
            for (int w = 0; w < 16; ++w) { sv += red[(tid * 16 + w) * 2]; qv += red[(tid * 16 + w) * 2 + 1]; }
            st[(tid * 8 + u.pn) * 2] = sv; st[(tid * 8 + u.pn) * 2 + 1] = qv;
        }
        asm volatile("s_waitcnt vmcnt(0)" ::: "memory");
        __syncthreads();
        if (tid == 0) {
            __hip_atomic_fetch_add(cnt + u.pm, 1u, __ATOMIC_RELEASE, __HIP_MEMORY_SCOPE_AGENT);
            while (__hip_atomic_load(cnt + u.pm, __ATOMIC_RELAXED, __HIP_MEMORY_SCOPE_AGENT) < 8u) __builtin_amdgcn_s_sleep(1);
        }
        __syncthreads();
        if (tid < 256) {
            __builtin_amdgcn_fence(__ATOMIC_ACQUIRE, "agent");
            float sv = 0.f, qv = 0.f;
#pragma unroll
            for (int w = 0; w < 8; ++w) {
                sv += __builtin_nontemporal_load(st + (tid * 8 + w) * 2); qv += __builtin_nontemporal_load(st + (tid * 8 + w) * 2 + 1);
            }
            const float mu = sv * (1.0f / D), var = fmaxf(qv * (1.0f / D) - mu * mu, 0.f);
            mr[tid * 2] = mu; mr[tid * 2 + 1] = rsqrtf(var + 1e-5f);
        }
        __syncthreads();
        {
            float mu[8], rs_[8];
#pragma unroll
            for (int ai = 0; ai < 2; ++ai)
#pragma unroll
                for (int m = 0; m < 4; ++m) { const int rl = ai * 128 + wr * 64 + m * 16 + fr; mu[ai * 4 + m] = mr[rl * 2]; rs_[ai * 4 + m] = mr[rl * 2 + 1]; }
#pragma unroll
            for (int bj = 0; bj < 2; ++bj) {
                const int c = col0 + bj * 128;
                f32x4 gmv[2], btv[2], shv[2], scv[2];
#pragma unroll
                for (int n = 0; n < 2; ++n) {
                    gmv[n] = *(const f32x4*)(gam + c + 4 * n); btv[n] = *(const f32x4*)(bet + c + 4 * n);
                    shv[n] = (f32x4){0.f, 0.f, 0.f, 0.f}; scv[n] = shv[n];
                    if (hmods) { const float* hm = hmods + (size_t)cond * 12288 + c + 4 * n; shv[n] = *(const f32x4*)hm; scv[n] = 1.0f + *(const f32x4*)(hm + 2048); }
                }
#pragma unroll
                for (int ai = 0; ai < 2; ++ai)
#pragma unroll
                    for (int m = 0; m < 4; ++m) {
                        const int r = u.pm * 256 + ai * 128 + wr * 64 + m * 16 + fr;
                        const f32x4 y0 = (acc[ai][bj][m][0] - mu[ai * 4 + m]) * rs_[ai * 4 + m] * gmv[0] + btv[0];
                        const f32x4 y1 = (acc[ai][bj][m][1] - mu[ai * 4 + m]) * rs_[ai * 4 + m] * gmv[1] + btv[1];
                        *(f32x4*)(xout + (size_t)r * xs_out + c) = y0; *(f32x4*)(xout + (size_t)r * xs_out + c + 4) = y1;
                        if (hmods) {
                            const f32x4 h0 = y0 * scv[0] + shv[0], h1 = y1 * scv[1] + shv[1];
                            const u32x4 o = {cvt_pk_bf16(h0[0], h0[1]), cvt_pk_bf16(h0[2], h0[3]), cvt_pk_bf16(h1[0], h1[1]), cvt_pk_bf16(h1[2], h1[3])};
                            *(u32x4*)(H + (size_t)r * D + c) = o;
                        }
                    }
            }
        }
    }
};
struct EpiU {
    static constexpr bool PERM = true, AFTER_DRAIN = false;
    bf16_t* U;
    DEVI void operator()(const f32x4 (&acc)[2][2][4][2], const pg8::Unit& u, int wr, int wc, int fr, int fq) const {
        asm volatile("" : "+v"(fr), "+v"(fq), "+s"(wr), "+s"(wc));
        const int row0 = u.pm * 256 + wr * 64 + fr, col0 = u.pn * 256 + wc * 32 + 8 * fq;
#pragma unroll
        for (int ai = 0; ai < 2; ++ai)
#pragma unroll
            for (int m = 0; m < 4; ++m) {
                bf16_t* ur = U + (size_t)(row0 + ai * 128 + m * 16) * NUP + col0;
#pragma unroll
                for (int bj = 0; bj < 2; ++bj) {
                    const f32x4 v0 = acc[ai][bj][m][0], v1 = acc[ai][bj][m][1];
                    const u32x4 o = {cvt_pk_bf16(v0[0], v0[1]), cvt_pk_bf16(v0[2], v0[3]), cvt_pk_bf16(v1[0], v1[1]), cvt_pk_bf16(v1[2], v1[3])};
                    *(u32x4*)(ur + bj * 128) = o;
                }
            }
    }
};

DEVI void ln_phase(const P& p, int l, int which) {
    const int lane = TIDX() & 63, wid = TIDX() >> 6;
    float* X = (float*)(WSP(p.ws) + W_X);
    const float* gam = p.in[which ? I_LN2G : I_LN1G] + l * D;
    const float* bet = p.in[which ? I_LN2B : I_LN1B] + l * D;
    const bool last = which == 1 && l == 1;
    const float* mods = (const float*)(WSP(p.ws) + W_MODS) + (size_t)(which ? l + 1 : l) * 36864 + (which ? 0 : 3 * 2048);
    bf16_t* H = (bf16_t*)(WSP(p.ws) + W_H);
    f32x4 gv[8], bv[8];
#pragma unroll
    for (int j = 0; j < 8; ++j) { gv[j] = *(const f32x4*)(gam + 4 * lane + 256 * j); bv[j] = *(const f32x4*)(bet + 4 * lane + 256 * j); }
    const int wstride = gridDim.x * 8;
    for (int t0 = BIDX() * 8 + wid; t0 < T; t0 += 2 * wstride) {
        const int t1 = t0 + wstride;
        const bool has1 = t1 < T;
        f32x4 v0[8], v1[8];
        float s0 = 0.f, s1 = 0.f;
#pragma unroll
        for (int j = 0; j < 8; ++j) v0[j] = *(const f32x4*)(X + (size_t)t0 * D + 4 * lane + 256 * j);
#pragma unroll
        for (int j = 0; j < 8; ++j) v1[j] = has1 ? *(const f32x4*)(X + (size_t)t1 * D + 4 * lane + 256 * j) : (f32x4){0.f, 0.f, 0.f, 0.f};
#pragma unroll
        for (int j = 0; j < 8; ++j) { s0 += v0[j][0] + v0[j][1] + v0[j][2] + v0[j][3]; s1 += v1[j][0] + v1[j][1] + v1[j][2] + v1[j][3]; }
#pragma unroll
        for (int o = 32; o > 0; o >>= 1) { s0 += __shfl_xor(s0, o); s1 += __shfl_xor(s1, o); }
        const float mu0 = s0 * (1.0f / D), mu1 = s1 * (1.0f / D);
        float q0 = 0.f, q1 = 0.f;
#pragma unroll
        for (int j = 0; j < 8; ++j) {
            v0[j] -= mu0; v1[j] -= mu1;
            q0 += v0[j][0] * v0[j][0] + v0[j][1] * v0[j][1] + v0[j][2] * v0[j][2] + v0[j][3] * v0[j][3];
            q1 += v1[j][0] * v1[j][0] + v1[j][1] * v1[j][1] + v1[j][2] * v1[j][2] + v1[j][3] * v1[j][3];
        }
#pragma unroll
        for (int o = 32; o > 0; o >>= 1) { q0 += __shfl_xor(q0, o); q1 += __shfl_xor(q1, o); }
        const float r0 = rsqrtf(q0 * (1.0f / D) + 1e-5f), r1 = rsqrtf(q1 * (1.0f / D) + 1e-5f);
#pragma unroll
        for (int rr = 0; rr < 2; ++rr) {
            if (rr == 1 && !has1) break;
            const int t = rr ? t1 : t0;
            const float rstd = rr ? r1 : r0;
            float* dst = last ? p.out + O_Y + (size_t)t * D : X + (size_t)t * D;
            const float* mr = mods + (size_t)cond_of_row(t) * 12288;
#pragma unroll
            for (int j = 0; j < 8; ++j) {
                const int c = 4 * lane + 256 * j;
                const f32x4 y = (rr ? v1[j] : v0[j]) * rstd * gv[j] + bv[j];
                *(f32x4*)(dst + c) = y;
                if (!last) st4(H + (size_t)t * D + c, y * (1.0f + *(const f32x4*)(mr + 2048 + c)) + *(const f32x4*)(mr + c));
            }
        }
    }
}

DEVI void conv_phase(const P& p, int l) {
    const bf16_t* U = (const bf16_t*)(WSP(p.ws) + W_U);
    bf16_t* A = (bf16_t*)(WSP(p.ws) + W_ACT);
    const float* cw = p.in[I_CONVW] + (size_t)l * 3 * NUP;
    const float* cb = p.in[I_CONVB] + (size_t)l * NUP;
    for (int id = BIDX() * 512 + TIDX(); id < 512 * 688; id += gridDim.x * 512) {
        const int trun = id / 688, cgp = id % 688, j0 = cgp * 8, t0 = trun * 16;
        const int S = t0 < TC ? 256 : 2048;
        const int s0 = t0 < TC ? (t0 & 255) : ((t0 - TC) & 2047);
        float wa[3][8], wg[3][8], ba[8], bg[8];
#pragma unroll
        for (int k = 0; k < 3; ++k)
#pragma unroll
            for (int h = 0; h < 2; ++h) {
                const f32x4 x = *(const f32x4*)(cw + (size_t)k * NUP + j0 + 4 * h), y = *(const f32x4*)(cw + (size_t)k * NUP + DFF + j0 + 4 * h);
#pragma unroll
                for (int i = 0; i < 4; ++i) { wa[k][4 * h + i] = x[i]; wg[k][4 * h + i] = y[i]; }
            }
#pragma unroll
        for (int h = 0; h < 2; ++h) {
            const f32x4 x = *(const f32x4*)(cb + j0 + 4 * h), y = *(const f32x4*)(cb + DFF + j0 + 4 * h);
#pragma unroll
            for (int i = 0; i < 4; ++i) { ba[4 * h + i] = x[i]; bg[4 * h + i] = y[i]; }
        }
        const u32x4 zero = {0u, 0u, 0u, 0u};
        auto lda = [&](int t) { return *(const u32x4*)(U + (size_t)t * NUP + j0); };
        auto ldg = [&](int t) { return *(const u32x4*)(U + (size_t)t * NUP + DFF + j0); };
        u32x4 pa = s0 > 0 ? lda(t0 - 1) : zero, pg = s0 > 0 ? ldg(t0 - 1) : zero;
        u32x4 ca = lda(t0), cgv = ldg(t0);
        auto outrow = [&](int t, const u32x4& xa, const u32x4& ya, const u32x4& za, const u32x4& xg, const u32x4& yg, const u32x4& zg) {
            float o[8];
#pragma unroll
            for (int w = 0; w < 4; ++w) {
                const float a0 = wa[0][2 * w] * bflo(xa[w]) + wa[1][2 * w] * bflo(ya[w]) + wa[2][2 * w] * bflo(za[w]) + ba[2 * w];
                const float a1 = wa[0][2 * w + 1] * bfhi(xa[w]) + wa[1][2 * w + 1] * bfhi(ya[w]) + wa[2][2 * w + 1] * bfhi(za[w]) + ba[2 * w + 1];
                const float g0 = wg[0][2 * w] * bflo(xg[w]) + wg[1][2 * w] * bflo(yg[w]) + wg[2][2 * w] * bflo(zg[w]) + bg[2 * w];
                const float g1 = wg[0][2 * w + 1] * bfhi(xg[w]) + wg[1][2 * w + 1] * bfhi(yg[w]) + wg[2][2 * w + 1] * bfhi(zg[w]) + bg[2 * w + 1];
                o[2 * w] = siluf_(g0) * a0; o[2 * w + 1] = siluf_(g1) * a1;
            }
            const u32x4 ov = {cvt_pk_bf16(o[0], o[1]), cvt_pk_bf16(o[2], o[3]), cvt_pk_bf16(o[4], o[5]), cvt_pk_bf16(o[6], o[7])};
            *(u32x4*)(A + (size_t)t * DFF + j0) = ov;
        };
        for (int i = 0; i < 16; i += 4) {
            const int t = t0 + i;
            u32x4 na[4], ng[4];
#pragma unroll
            for (int k = 0; k < 4; ++k) {
                const bool hn = (s0 + i + k + 1) < S;
                na[k] = hn ? lda(t + k + 1) : zero; ng[k] = hn ? ldg(t + k + 1) : zero;
            }
            outrow(t, pa, ca, na[0], pg, cgv, ng[0]);
            outrow(t + 1, ca, na[0], na[1], cgv, ng[0], ng[1]);
            outrow(t + 2, na[0], na[1], na[2], ng[0], ng[1], ng[2]);
            outrow(t + 3, na[1], na[2], na[3], ng[1], ng[2], ng[3]);
            pa = na[2]; pg = ng[2]; ca = na[3]; cgv = ng[3];
        }
    }
}

constexpr size_t LATV_A = (size_t)16 * 6 * 32768, LATV_B = (size_t)16 * 5 * 32768;
template <bool DIFF>
DEVI void attn_item(const bf16_t* qrow0, const bf16_t* qrow1,
                    const bf16_t* K0, int ks0, int kstart0, int tstep0, int nt0, const bf16_t* VT0, int vs0,
                    const bf16_t* K1, int ks1, int nt1, const bf16_t* VT1, int vs1,
                    bool neigh, int qr, int qc0, int c0, int rs, const float* rpb_h,
                    float sc2, bf16_t* yrow, float lam, const float* subln, float outscale) {
    constexpr int NMAP = DIFF ? 2 : 1, NKK = DIFF ? 2 : 4;
    const int lane = TIDX() & 63, l16 = lane & 15, g = lane >> 4;
    float mrun[NMAP], lrun[NMAP];
    f32x4 o[NMAP][8];
#pragma unroll
    for (int mp = 0; mp < NMAP; ++mp) {
        mrun[mp] = -1e30f; lrun[mp] = 0.f;
#pragma unroll
        for (int dt = 0; dt < 8; ++dt) o[mp][dt] = (f32x4){0.f, 0.f, 0.f, 0.f};
    }
    bf16x8 qf[NMAP][NKK];
#pragma unroll
    for (int mp = 0; mp < NMAP; ++mp)
#pragma unroll
        for (int kk = 0; kk < NKK; ++kk) qf[mp][kk] = ld8(qrow0 + (mp * NKK + kk) * 32 + 8 * g);
    const int qc = qc0 + l16, cs = clampi(qc - 8, 0, 48);
    const int ntot = nt0 + nt1;
    for (int j = 0; j < ntot; ++j) {
        const bool s0 = j < nt0;
        if (j == nt0 && qrow1 != qrow0) {
#pragma unroll
            for (int mp = 0; mp < NMAP; ++mp)
#pragma unroll
                for (int kk = 0; kk < NKK; ++kk) qf[mp][kk] = ld8(qrow1 + (mp * NKK + kk) * 32 + 8 * g);
        }
        const int key0 = s0 ? kstart0 + j * tstep0 : (j - nt0) * 32;
        const int ks = s0 ? ks0 : ks1, vs = s0 ? vs0 : vs1;
        const bf16_t* Kt = (s0 ? K0 : K1) + (size_t)key0 * ks + (size_t)l16 * ks + 8 * g;
        const bf16_t* Vt = (s0 ? VT0 : VT1) + key0 + (size_t)l16 * vs + 4 * g;
        f32x4 s[NMAP][2];
#pragma unroll
        for (int mp = 0; mp < NMAP; ++mp)
#pragma unroll
            for (int half = 0; half < 2; ++half) {
                f32x4 a = {0.f, 0.f, 0.f, 0.f};
#pragma unroll
                for (int kk = 0; kk < NKK; ++kk) a = mfma16(ld8(Kt + (size_t)(16 * half) * ks + (mp * NKK + kk) * 32), qf[mp][kk], a);
                s[mp][half] = a;
            }
        bf16x8 vf[8];
#pragma unroll
        for (int dt = 0; dt < 8; ++dt) vf[dt] = ld4x2(Vt + (size_t)(16 * dt) * vs, Vt + (size_t)(16 * dt) * vs + 16);
#pragma unroll
        for (int mp = 0; mp < NMAP; ++mp) {
            float v[8];
#pragma unroll
            for (int half = 0; half < 2; ++half)
#pragma unroll
                for (int i = 0; i < 4; ++i) v[half * 4 + i] = s[mp][half][i] * sc2;
            if (neigh && s0) {
                const float* brow = rpb_h + (7 + rs + j - qr) * 31;
#pragma unroll
                for (int half = 0; half < 2; ++half)
#pragma unroll
                    for (int i = 0; i < 4; ++i) {
                        const int kc = c0 + 16 * half + 4 * g + i;
                        const bool ok = kc >= cs && kc < cs + 16;
                        const float bv = brow[clampi(kc - qc + 15, 0, 30)] * LOG2E;
                        v[half * 4 + i] = ok ? v[half * 4 + i] + bv : -1e30f;
                    }
            }
            float tm = fmaxf(fmaxf(fmaxf(v[0], v[1]), fmaxf(v[2], v[3])), fmaxf(fmaxf(v[4], v[5]), fmaxf(v[6], v[7])));
            tm = fmaxf(tm, __shfl_xor(tm, 16)); tm = fmaxf(tm, __shfl_xor(tm, 32));
            const float mnew = fmaxf(mrun[mp], tm), alpha = ex2(mrun[mp] - mnew);
            mrun[mp] = mnew;
            f32x4 p0, p1; float ps = 0.f;
#pragma unroll
            for (int i = 0; i < 4; ++i) { p0[i] = ex2(v[i] - mnew); p1[i] = ex2(v[4 + i] - mnew); ps += p0[i] + p1[i]; }
            lrun[mp] = lrun[mp] * alpha + ps;
            const bf16x8 pb = pack8(p0, p1);
#pragma unroll
            for (int dt = 0; dt < 8; ++dt) o[mp][dt] = mfma16(vf[dt], pb, o[mp][dt] * alpha);
        }
    }
    float inv[NMAP];
#pragma unroll
    for (int mp = 0; mp < NMAP; ++mp) { float lsum = lrun[mp]; lsum += __shfl_xor(lsum, 16); lsum += __shfl_xor(lsum, 32); inv[mp] = 1.0f / lsum; }
    if constexpr (!DIFF) {
#pragma unroll
        for (int dt = 0; dt < 8; ++dt) st4(yrow + 16 * dt + 4 * g, o[0][dt] * inv[0]);
    } else {
        float ss = 0.f;
        f32x4 ov[8];
#pragma unroll
        for (int dt = 0; dt < 8; ++dt) {
            ov[dt] = o[0][dt] * inv[0] - (lam * inv[1]) * o[1][dt];
            ss += ov[dt][0] * ov[dt][0] + ov[dt][1] * ov[dt][1] + ov[dt][2] * ov[dt][2] + ov[dt][3] * ov[dt][3];
        }
        ss += __shfl_xor(ss, 16); ss += __shfl_xor(ss, 32);
        const float rinv = rsqrtf(ss * (1.0f / 128.0f) + 1e-6f) * outscale;
#pragma unroll
        for (int dt = 0; dt < 8; ++dt) st4(yrow + 16 * dt + 4 * g, ov[dt] * rinv * *(const f32x4*)(subln + 16 * dt + 4 * g));
    }
}

DEVI float incl_scan_sum(float v, int lane) {
#pragma unroll
    for (int o = 1; o < 64; o <<= 1) { const float t = __shfl_up(v, o); if (lane >= o) v += t; }
    return v;
}
DEVI float incl_scan_max(float v, int lane) {
#pragma unroll
    for (int o = 1; o < 64; o <<= 1) { const float t = __shfl_up(v, o); if (lane >= o) v = fmaxf(v, t); }
    return v;
}
DEVI bf16x8 ones_row(int l16) { const short v = (short)(l16 == 0 ? 0x3F80 : 0); return (bf16x8){v, v, v, v, v, v, v, v}; }
DEVI bf16x8 ldf8(const float* p) { return pack8(*(const f32x4*)p, *(const f32x4*)(p + 4)); }

DEVI void m1_item(const P& p, int slot) {
    const int lane = TIDX() & 63, l16 = lane & 15, g = lane >> 4;
    int chunk, dir, bh, tok0, vs; size_t tb;
    if (slot < 640) { chunk = slot & 3; dir = (slot >> 2) & 1; bh = slot >> 3; tok0 = (bh / 5) * 256 + chunk * 64; vs = 256; tb = (size_t)bh * 128 * 256 + chunk * 64; }
    else { const int q = slot - 640; chunk = q & 31; dir = (q >> 5) & 1; bh = q >> 6; tok0 = TC + (bh / 5) * 2048 + chunk * 64; vs = 2048; tb = LATV_B + (size_t)bh * 128 * 2048 + chunk * 64; }
    const int h = bh % 5;
    char* ws = WSP(p.ws);
    const float* G = (const float*)(ws + W_G) + (size_t)(tok0 + lane) * 20;
    const float f = G[(dir ? 15 : 5) + h], ig = G[(dir ? 10 : 0) + h];
    const bf16_t* vct = (const bf16_t*)(ws + W_VCT) + tb + (size_t)l16 * vs + 8 * g;
    bf16x8 vf[8][2];
#pragma unroll
    for (int et = 0; et < 8; ++et)
#pragma unroll
        for (int ks = 0; ks < 2; ++ks) vf[et][ks] = ld8(vct + (size_t)(16 * et) * vs + 32 * ks);
    const float ps = incl_scan_sum(f, lane), total = __shfl(ps, 63);
    const float gs = (dir ? ps - f : total - ps) + ig;
    const float mloc = wave_max(gs), w = __expf(gs - mloc);
    float wv[2][8];
#pragma unroll
    for (int ks = 0; ks < 2; ++ks)
#pragma unroll
        for (int j = 0; j < 8; ++j) wv[ks][j] = __shfl(w, 32 * ks + 8 * g + j);
    const bf16x8 on = ones_row(l16);
    const bf16_t* kct0 = (const bf16_t*)(ws + W_KCT) + tb + (size_t)l16 * vs + 8 * g;
    float* ST0 = (float*)(ws + W_ST) + (size_t)slot * 16384 + l16;
    float* SN0 = (float*)(ws + W_SN) + (size_t)slot * 128 + l16;
#pragma unroll 1
    for (int dt = 0; dt < 8; ++dt) {
        const bf16_t* kct = kct0 + (size_t)(16 * dt) * vs;
        bf16x8 bk[2];
#pragma unroll
        for (int ks = 0; ks < 2; ++ks) {
            const u32x4 raw = *(const u32x4*)(kct + 32 * ks);
            const u32x4 r = {cvt_pk_bf16(bflo(raw[0]) * wv[ks][0], bfhi(raw[0]) * wv[ks][1]), cvt_pk_bf16(bflo(raw[1]) * wv[ks][2], bfhi(raw[1]) * wv[ks][3]),
                             cvt_pk_bf16(bflo(raw[2]) * wv[ks][4], bfhi(raw[2]) * wv[ks][5]), cvt_pk_bf16(bflo(raw[3]) * wv[ks][6], bfhi(raw[3]) * wv[ks][7])};
            bk[ks] = __builtin_bit_cast(bf16x8, r);
        }
        float* ST = ST0 + 16 * dt;
#pragma unroll
        for (int et = 0; et < 8; ++et) {
            f32x4 a = {0.f, 0.f, 0.f, 0.f};
#pragma unroll
            for (int ks = 0; ks < 2; ++ks) a = mfma16(vf[et][ks], bk[ks], a);
#pragma unroll
            for (int i = 0; i < 4; ++i) ST[(16 * et + 4 * g + i) * 128] = a[i];
        }
        f32x4 a = {0.f, 0.f, 0.f, 0.f};
#pragma unroll
        for (int ks = 0; ks < 2; ++ks) a = mfma16(on, bk[ks], a);
        if (g == 0) SN0[16 * dt] = a[0];
    }
    if (lane == 0) { float* SS = (float*)(ws + W_SS); SS[slot] = total; SS[1920 + slot] = mloc; }
}

template <int NC>
DEVI void m2_chain(float* base, size_t sstride, bf16_t* sb, float* SS, int slot0, int dir, bool act, bool wr_m, f32x4& C, float& m) {
    f32x4 kv[NC]; float bl[NC], ml[NC];
#pragma unroll
    for (int u = 0; u < NC; ++u) {
        const int slot = slot0 + (dir ? NC - 1 - u : u);
        kv[u] = act ? *(const f32x4*)(base + (size_t)slot * sstride) : (f32x4){0.f, 0.f, 0.f, 0.f};
        bl[u] = SS[slot]; ml[u] = SS[1920 + slot];
    }
#pragma unroll
    for (int u = 0; u < NC; ++u) {
        const int slot = slot0 + (dir ? NC - 1 - u : u);
        const float mnew = fmaxf(bl[u] + m, ml[u]), wold = __expf(bl[u] + m - mnew), wnew = __expf(ml[u] - mnew);
        if (act) { if (sb) st4(sb + (size_t)slot * 16384, C); else *(f32x4*)(base + (size_t)slot * sstride) = C; }
        if (wr_m) SS[2 * 1920 + slot] = m;
        C = wold * C + wnew * kv[u];
        m = mnew;
    }
}
DEVI void m2_phase(const P& p, int l) {
    const int tid = TIDX();
    char* ws = WSP(p.ws);
    float* SS = (float*)(ws + W_SS);
    for (int it = BIDX(); it < 180 * 9; it += gridDim.x) {
        const int sd = it / 9, slice = it % 9;
        const bool lat = sd < 20;
        const int q = lat ? sd : sd - 20, dir = q & 1, bh = q >> 1, b = bh / 5, h = bh % 5;
        const int slot0 = lat ? 640 + (bh * 2 + dir) * 32 : (bh * 2 + dir) * 4;
        const size_t sidx = (size_t)((b * 2 + l) * 2 + dir) * 5 + h;
        float m = lat ? p.in[I_SM][sidx] : 0.f;
        const bool act = slice < 8 || tid < 32;
        const int eo = slice < 8 ? slice * 2048 + tid * 4 : 0;
        const int e = eo >> 7, d0 = slice < 8 ? (eo & 127) : tid * 4;
        f32x4 C = {0.f, 0.f, 0.f, 0.f};
        if (lat && act) {
            if (slice < 8) { const float* ci = p.in[I_SC] + sidx * 16384;
#pragma unroll
                for (int i = 0; i < 4; ++i) C[i] = ci[(d0 + i) * 128 + e]; }
            else C = *(const f32x4*)(p.in[I_SN] + sidx * 128 + d0);
        }
        float* base = slice < 8 ? (float*)(ws + W_ST) + eo : (float*)(ws + W_SN) + d0;
        const size_t sstride = slice < 8 ? 16384 : 128;
        const bool wr_m = slice == 0 && tid == 0;
        bf16_t* sb = slice < 8 ? (bf16_t*)(ws + W_ACT) + eo : nullptr;
        if (lat) m2_chain<32>(base, sstride, sb, SS, slot0, dir, act, wr_m, C, m);
        else m2_chain<4>(base, sstride, sb, SS, slot0, dir, act, wr_m, C, m);
        if (!lat && act) {
            if (slice < 8) { float* co = p.out + O_CC + sidx * 16384;
#pragma unroll
                for (int i = 0; i < 4; ++i) co[(d0 + i) * 128 + e] = C[i]; }
            else *(f32x4*)(p.out + O_CN + sidx * 128 + d0) = C;
            if (slice == 0 && tid == 0) p.out[O_CM + sidx] = m;
        }
    }
}

DEVI void m3_item(const P& p, int l, int idx) {
    const int lane = TIDX() & 63, l16 = lane & 15, g = lane >> 4;
    const int tt = idx & 3, cidx = idx >> 2;
    int bh, chunk, tok0, vs, slotf, slotb; size_t tb;
    if (cidx < 320) { bh = cidx >> 2; chunk = cidx & 3; tok0 = (bh / 5) * 256 + chunk * 64; vs = 256; tb = (size_t)bh * 128 * 256 + chunk * 64; slotf = (bh * 2) * 4 + chunk; slotb = (bh * 2 + 1) * 4 + chunk; }
    else { const int q = cidx - 320; bh = q >> 5; chunk = q & 31; tok0 = TC + (bh / 5) * 2048 + chunk * 64; vs = 2048; tb = LATV_B + (size_t)bh * 128 * 2048 + chunk * 64; slotf = 640 + (bh * 2) * 32 + chunk; slotb = 640 + (bh * 2 + 1) * 32 + chunk; }
    const int h = bh % 5, tq = 16 * tt + l16;
    const bf16_t* qrow = (const bf16_t*)(WSP(p.ws) + W_QC) + (size_t)(tok0 + tq) * 640 + h * 128 + 8 * g;
    bf16x8 qf[4];
#pragma unroll
    for (int kk = 0; kk < 4; ++kk) qf[kk] = ld8(qrow + 32 * kk);
    f32x4 sT[4];
    {
        const bf16_t* kb = (const bf16_t*)(WSP(p.ws) + W_KC) + (size_t)(tok0 + l16) * 640 + h * 128 + 8 * g;
#pragma unroll
        for (int st = 0; st < 4; ++st) {
            f32x4 a = {0.f, 0.f, 0.f, 0.f};
#pragma unroll
            for (int kk = 0; kk < 4; ++kk) a = mfma16(ld8(kb + (size_t)(16 * st) * 640 + 32 * kk), qf[kk], a);
            sT[st] = a;
        }
    }
    f32x4 hsum[8];
#pragma unroll
    for (int et = 0; et < 8; ++et) hsum[et] = (f32x4){0.f, 0.f, 0.f, 0.f};
    const float* Gp = (const float*)(WSP(p.ws) + W_G) + (size_t)(tok0 + lane) * 20;
    const float* SS = (const float*)(WSP(p.ws) + W_SS);
    const bf16_t* vtb = (const bf16_t*)(WSP(p.ws) + W_VCT) + tb + (size_t)l16 * vs + 4 * g;
    for (int dir = 0; dir < 2; ++dir) {
        const int slot = dir ? slotb : slotf;
        float f = Gp[(dir ? 15 : 5) + h], ig = Gp[(dir ? 10 : 0) + h];
        if (dir) { f = __shfl(f, 63 - lane); ig = __shfl(ig, 63 - lane); }
        const float bs = incl_scan_sum(f, lane);
        float a_ = ig - bs;
        const float pm = incl_scan_max(a_, lane);
        const float mst = SS[2 * 1920 + slot];
        const float mrow = bs + fmaxf(pm, mst);
        float c_ = bs - mrow, wst = __expf(bs + mst - mrow), emr = __expf(-mrow);
        if (dir) { a_ = __shfl(a_, 63 - lane); c_ = __shfl(c_, 63 - lane); wst = __shfl(wst, 63 - lane); emr = __shfl(emr, 63 - lane); }
        const float cq = __shfl(c_, tq), wq = __shfl(wst, tq), eq = __shfl(emr, tq);
        f32x4 o[9];
        const bf16_t* Cs = (const bf16_t*)(WSP(p.ws) + W_ACT) + (size_t)slot * 16384 + (size_t)l16 * 128 + 8 * g;
#pragma unroll
        for (int et = 0; et < 8; ++et) {
            f32x4 a = {0.f, 0.f, 0.f, 0.f};
#pragma unroll
            for (int kk = 0; kk < 4; ++kk) a = mfma16(ld8(Cs + (size_t)(16 * et) * 128 + 32 * kk), qf[kk], a);
            o[et] = a * wq;
        }
        {
            const float* ns = (const float*)(WSP(p.ws) + W_SN) + (size_t)slot * 128 + 8 * g;
            f32x4 a = {0.f, 0.f, 0.f, 0.f};
#pragma unroll
            for (int kk = 0; kk < 4; ++kk) {
                bf16x8 nf = ldf8(ns + 32 * kk);
                if (l16 != 0) nf = (bf16x8){0, 0, 0, 0, 0, 0, 0, 0};
                a = mfma16(nf, qf[kk], a);
            }
            o[8] = a * wq;
        }
        const bf16x8 on = ones_row(l16);
#pragma unroll
        for (int ks = 0; ks < 2; ++ks) {
            f32x4 pp[2];
#pragma unroll
            for (int half = 0; half < 2; ++half) {
                const int st = 2 * ks + half;
#pragma unroll
                for (int i = 0; i < 4; ++i) {
                    const int s = 16 * st + 4 * g + i;
                    const float as = __shfl(a_, s);
                    const bool ok = dir ? (s >= tq) : (s <= tq);
                    pp[half][i] = ok ? sT[st][i] * __expf(as + cq) : 0.f;
                }
            }
            const bf16x8 pb = pack8(pp[0], pp[1]);
#pragma unroll
            for (int et = 0; et < 8; ++et) o[et] = mfma16(ld4x2(vtb + (size_t)(16 * et) * vs + 32 * ks, vtb + (size_t)(16 * et) * vs + 32 * ks + 16), pb, o[et]);
            o[8] = mfma16(on, pb, o[8]);
        }
        const float den = __shfl(o[8][0], l16);
        const float dinv = 1.0f / fmaxf(fabsf(den), eq);
#pragma unroll
        for (int et = 0; et < 8; ++et) hsum[et] += o[et] * dinv;
    }
    float ss = 0.f;
#pragma unroll
    for (int et = 0; et < 8; ++et) ss += hsum[et][0] * hsum[et][0] + hsum[et][1] * hsum[et][1] + hsum[et][2] * hsum[et][2] + hsum[et][3] * hsum[et][3];
    ss += __shfl_xor(ss, 16); ss += __shfl_xor(ss, 32);
    const float rinv = rsqrtf(ss * (1.0f / 128.0f) + 1e-6f);
    const bf16_t* og = (const bf16_t*)(WSP(p.ws) + W_OG) + (size_t)(tok0 + tq) * 640 + h * 128 + 4 * g;
    const float* cn = p.in[I_CNORM] + l * 128 + 4 * g;
    bf16_t* y = (bf16_t*)(WSP(p.ws) + W_Y) + (size_t)(tok0 + tq) * D + 1408 + h * 128 + 4 * g;
#pragma unroll
    for (int et = 0; et < 8; ++et) {
        const u32x2 ou = *(const u32x2*)(og + 16 * et);
        const f32x4 ogf = {bflo(ou[0]), bfhi(ou[0]), bflo(ou[1]), bfhi(ou[1])};
        st4(y + 16 * et, hsum[et] * rinv * *(const f32x4*)(cn + 16 * et) * ogf);
    }
}

#ifndef ABUF
#define ABUF 0
#endif
constexpr int KROW = 136, VROW = 72;
constexpr int KT_EL = 64 * KROW, VT_EL = 128 * VROW;
constexpr int ATT_LDS_BYTES = (2 * KT_EL + 2 * VT_EL) * 2;
typedef PG8_LAS const bf16x8* lds_b8p;
typedef PG8_LAS const u32x2* lds_u2p;
template <int N> struct IC { static constexpr int value = N; };
template <bool DIFF, bool NEIGH>
DEVI void attn_block(PG8_LAS unsigned char* lds, const bf16_t* qrow0, const bf16_t* qrow1,
                     const bf16_t* K0, int ks0, int kstart0, int nt0, const bf16_t* VT0, int vs0,
                     const bf16_t* K1, int ks1, int nt1, const bf16_t* VT1, int vs1,
                     int qr, int qc0, int c0, int rs, int rsmin, const float* rpb_h,
                     float sc2, bf16_t* yrow, float lam, const float* subln, float outscale) {
    constexpr int NMAP = DIFF ? 2 : 1, NKK = DIFF ? 2 : 4;
    const int tid = TIDX(), lane = tid & 63, l16 = lane & 15, g = lane >> 4;
    float mrun[NMAP], lrun[NMAP];
    f32x4 o[NMAP][8];
#pragma unroll
    for (int mp = 0; mp < NMAP; ++mp) {
        mrun[mp] = -1e30f; lrun[mp] = 0.f;
#pragma unroll
        for (int dt = 0; dt < 8; ++dt) o[mp][dt] = (f32x4){0.f, 0.f, 0.f, 0.f};
    }
    bf16x8 qf[NMAP][NKK];
#pragma unroll
    for (int mp = 0; mp < NMAP; ++mp)
#pragma unroll
        for (int kk = 0; kk < NKK; ++kk) qf[mp][kk] = ld8(qrow0 + (mp * NKK + kk) * 32 + 8 * g);
    const int qc = qc0 + l16, cs = clampi(qc - 8, 0, 48);
    const int ntot = nt0 + nt1;
    u32x4 kreg[2], vreg[2];
    auto gload = [&](int t) {
        const bool s0 = t < nt0;
        const int key0 = s0 ? kstart0 + 64 * t : 64 * (t - nt0);
        const bf16_t* Kb = s0 ? K0 : K1; const bf16_t* Vb = s0 ? VT0 : VT1;
        const int ks = s0 ? ks0 : ks1, vs = s0 ? vs0 : vs1;
#pragma unroll
        for (int i = 0; i < 2; ++i) {
            const int c = tid + 512 * i;
            kreg[i] = *(const __attribute__((address_space(1))) u32x4*)(Kb + (size_t)(key0 + (c >> 4)) * ks + (c & 15) * 8);
            vreg[i] = *(const __attribute__((address_space(1))) u32x4*)(Vb + (size_t)(c >> 3) * vs + key0 + (c & 7) * 8);
        }
    };
    auto lstore = [&]() {
#pragma unroll
        for (int i = 0; i < 2; ++i) {
            const int c = tid + 512 * i;
            *(PG8_LAS u32x4*)(lds + ((c >> 4) * KROW + (c & 15) * 8) * 2) = kreg[i];
            *(PG8_LAS u32x4*)(lds + (2 * KT_EL + (c >> 3) * VROW + (c & 7) * 8) * 2) = vreg[i];
        }
    };
    PG8_LAS unsigned char* Kt = lds;
    PG8_LAS unsigned char* Vt = lds + (2 * KT_EL) * 2;
    auto step = [&](auto nsc, int kofs, bool win, int kr) {
        constexpr int NS = decltype(nsc)::value;
        f32x4 s[NMAP][NS][2];
#pragma unroll
        for (int sub = 0; sub < NS; ++sub)
#pragma unroll
            for (int mp = 0; mp < NMAP; ++mp)
#pragma unroll
                for (int half = 0; half < 2; ++half) {
                    f32x4 a = {0.f, 0.f, 0.f, 0.f};
#pragma unroll
                    for (int kk = 0; kk < NKK; ++kk) a = mfma16(*(lds_b8p)(Kt + ((kofs + 32 * sub + 16 * half + l16) * KROW + (mp * NKK + kk) * 32 + 8 * g) * 2), qf[mp][kk], a);
                    s[mp][sub][half] = a;
                }
        bf16x8 pb[NMAP][NS]; float alpha[NMAP];
#pragma unroll
        for (int mp = 0; mp < NMAP; ++mp) {
            float v[NS * 8];
#pragma unroll
            for (int sub = 0; sub < NS; ++sub)
#pragma unroll
                for (int half = 0; half < 2; ++half)
#pragma unroll
                    for (int i = 0; i < 4; ++i) v[sub * 8 + half * 4 + i] = s[mp][sub][half][i] * sc2;
            if (NEIGH && win) {
                const float* brow = rpb_h + (7 + kr - qr) * 31;
#pragma unroll
                for (int half = 0; half < 2; ++half)
#pragma unroll
                    for (int i = 0; i < 4; ++i) {
                        const int kc = c0 + 16 * half + 4 * g + i;
                        const bool ok = kc >= cs && kc < cs + 16;
                        const float bv = brow[clampi(kc - qc + 15, 0, 30)] * LOG2E;
                        v[half * 4 + i] = ok ? v[half * 4 + i] + bv : -1e30f;
                    }
            }
            float tm = v[0];
#pragma unroll
            for (int i = 1; i < NS * 8; ++i) tm = fmaxf(tm, v[i]);
            tm = fmaxf(tm, __shfl_xor(tm, 16)); tm = fmaxf(tm, __shfl_xor(tm, 32));
            const float mnew = fmaxf(mrun[mp], tm);
            alpha[mp] = ex2(mrun[mp] - mnew);
            mrun[mp] = mnew;
            float ps = 0.f;
#pragma unroll
            for (int sub = 0; sub < NS; ++sub) {
                f32x4 p0, p1;
#pragma unroll
                for (int i = 0; i < 4; ++i) { p0[i] = ex2(v[sub * 8 + i] - mnew); p1[i] = ex2(v[sub * 8 + 4 + i] - mnew); ps += p0[i] + p1[i]; }
                pb[mp][sub] = pack8(p0, p1);
            }
            lrun[mp] = lrun[mp] * alpha[mp] + ps;
        }
#pragma unroll
        for (int dt = 0; dt < 8; ++dt) {
            f32x4 acc[NMAP];
#pragma unroll
            for (int mp = 0; mp < NMAP; ++mp) acc[mp] = o[mp][dt] * alpha[mp];
#pragma unroll
            for (int sub = 0; sub < NS; ++sub) {
                const u32x2 a = *(lds_u2p)(Vt + ((16 * dt + l16) * VROW + kofs + 32 * sub + 4 * g) * 2), b = *(lds_u2p)(Vt + ((16 * dt + l16) * VROW + kofs + 32 * sub + 16 + 4 * g) * 2);
                const u32x4 r = {a[0], a[1], b[0], b[1]};
                const bf16x8 vf = __builtin_bit_cast(bf16x8, r);
#pragma unroll
                for (int mp = 0; mp < NMAP; ++mp) acc[mp] = mfma16(vf, pb[mp][sub], acc[mp]);
            }
#pragma unroll
            for (int mp = 0; mp < NMAP; ++mp) o[mp][dt] = acc[mp];
        }
    };
    gload(0); lstore(); __syncthreads();
    for (int t = 0; t < ntot; ++t) {
        if (t == nt0 && qrow1 != qrow0) {
#pragma unroll
            for (int mp = 0; mp < NMAP; ++mp)
#pragma unroll
                for (int kk = 0; kk < NKK; ++kk) qf[mp][kk] = ld8(qrow1 + (mp * NKK + kk) * 32 + 8 * g);
        }
        if (t + 1 < ntot) gload(t + 1);
        if (NEIGH && t < nt0) {
            const int kr = rsmin + t;
            if (kr >= rs && kr < rs + 8) step(IC<1>{}, c0, true, kr);
        } else {
            step(IC<2>{}, 0, false, 0);
        }
        __syncthreads();
        if (t + 1 < ntot) lstore();
        __syncthreads();
    }
    float inv[NMAP];
#pragma unroll
    for (int mp = 0; mp < NMAP; ++mp) { float lsum = lrun[mp]; lsum += __shfl_xor(lsum, 16); lsum += __shfl_xor(lsum, 32); inv[mp] = 1.0f / lsum; }
    if constexpr (!DIFF) {
#pragma unroll
        for (int dt = 0; dt < 8; ++dt) st4(yrow + 16 * dt + 4 * g, o[0][dt] * inv[0]);
    } else {
        float ss = 0.f;
        f32x4 ov[8];
#pragma unroll
        for (int dt = 0; dt < 8; ++dt) {
            ov[dt] = o[0][dt] * inv[0] - (lam * inv[1]) * o[1][dt];
            ss += ov[dt][0] * ov[dt][0] + ov[dt][1] * ov[dt][1] + ov[dt][2] * ov[dt][2] + ov[dt][3] * ov[dt][3];
        }
        ss += __shfl_xor(ss, 16); ss += __shfl_xor(ss, 32);
        const float rinv = rsqrtf(ss * (1.0f / 128.0f) + 1e-6f) * outscale;
#pragma unroll
        for (int dt = 0; dt < 8; ++dt) st4(yrow + 16 * dt + 4 * g, ov[dt] * rinv * *(const f32x4*)(subln + 16 * dt + 4 * g));
    }
}

constexpr int N_BL = 160, N_AL = 192, N_M3 = 320, N_AC = 192, N_BC = 160, N_MIX = N_BL + N_AL + N_M3 + N_AC + N_BC;
DEVI void mixer_phase(const P& p, int l, PG8_LAS unsigned char* lds) {
    const int tid = TIDX(), lane = tid & 63;
    char* ws = WSP(p.ws);
    unsigned* cnt = (unsigned*)(ws + W_CNT) + 64 * l;
    const float lam_init = l == 0 ? 0.2f : 0.35550906759f;
    float lam;
    {
        const float* bl = p.in[I_LAMBDA] + l * 256;
        const float s1 = wave_sum(bl[lane] * bl[64 + lane]), s2 = wave_sum(bl[128 + lane] * bl[192 + lane]);
        lam = __expf(s1) - __expf(s2) + lam_init;
        lam = __int_as_float(__builtin_amdgcn_readfirstlane(__float_as_int(lam)));
    }
    const bf16_t* Qa = (const bf16_t*)(ws + W_QA); const bf16_t* Ka = (const bf16_t*)(ws + W_KA); const bf16_t* VaT = (const bf16_t*)(ws + W_VAT);
    const bf16_t* Qb = (const bf16_t*)(ws + W_QB); const bf16_t* Qbr = (const bf16_t*)(ws + W_QBR); const bf16_t* Kb = (const bf16_t*)(ws + W_KB); const bf16_t* VbT = (const bf16_t*)(ws + W_VBT);
    bf16_t* Y = (bf16_t*)(ws + W_Y);
    const float scA = 0.08838834764831845f * LOG2E, scB = 0.125f * LOG2E;
    const float* subln = p.in[I_SUBLN] + l * 128;
    PG8_LAS int* s_item = (PG8_LAS int*)(lds + ATT_LDS_BYTES);
#if STATIC_Q
    for (int idx0 = BIDX(); idx0 < N_MIX; idx0 += gridDim.x) {
        int idx = idx0;
#else
    for (;;) {
        if (tid == 0) *s_item = (int)atomicAdd(cnt, 1u);
        __syncthreads();
        int idx = *s_item;
        __syncthreads();
        if (idx >= N_MIX) break;
#endif
        const int tid2 = TIDX(), l16 = tid2 & 15, wv = tid2 >> 6;
#if PROBE
        if (tid == 0 && l == 0) {
            unsigned long long* ts = (unsigned long long*)(p.ws + W_CNT + 2048);
            if (idx == N_BL) ts[42] = wall_clock64();
            if (idx == N_BL + N_AL) ts[43] = wall_clock64();
            if (idx == N_BL + N_AL + N_M3) ts[44] = wall_clock64();
        }
#endif
        if (idx < N_BL) {
            const int b = idx / 80, h = (idx % 80) / 16, qb = idx % 16;
            const int tl = b * 2048 + qb * 128 + wv * 16 + l16, t = TC + tl;
            attn_block<true, false>(lds, Qbr + (size_t)tl * 640 + h * 128, Qb + (size_t)t * 640 + h * 128,
                             Kb + (size_t)(TC + b * 2048) * 640 + h * 128, 640, 0, 32, VbT + LATV_B + (size_t)(b * 5 + h) * 128 * 2048, 2048,
                             (const bf16_t*)(ws + W_CKB) + (size_t)((b * 2 + l) * 5 + h) * 65536, 128, 8, (const bf16_t*)(ws + W_CVB) + (size_t)((b * 2 + l) * 5 + h) * 65536, 512,
                             0, 0, 0, 0, 0, nullptr, scB, Y + (size_t)t * D + 768 + h * 128, lam, subln, 1.0f - lam_init);
            continue;
        }
        idx -= N_BL;
        if (idx < N_AL) {
            const int b = idx / 96, h = (idx % 96) / 16, rp = idx % 16;
            const int r0 = 2 * rp, r = r0 + (wv >> 2), q4 = wv & 3;
            const int qc0 = 16 * q4, c0 = clampi(qc0 - 8, 0, 32), rs = clampi(r - 4, 0, 24), rsmin = clampi(r0 - 4, 0, 24), rsmax = clampi(r0 + 1 - 4, 0, 24);
            const int t = TC + b * 2048 + r * 64 + qc0 + l16;
            const bf16_t* qrow = Qa + (size_t)t * 768 + h * 128;
            attn_block<false, true>(lds, qrow, qrow, Ka + (size_t)(TC + b * 2048) * 768 + h * 128, 768, rsmin * 64, rsmax + 8 - rsmin, VaT + LATV_A + (size_t)(b * 6 + h) * 128 * 2048, 2048,
                              (const bf16_t*)(ws + W_CKA) + (size_t)((b * 2 + l) * 6 + h) * 65536, 128, 8, (const bf16_t*)(ws + W_CVA) + (size_t)((b * 2 + l) * 6 + h) * 65536, 512,
                              r, qc0, c0, rs, rsmin, p.in[I_RPB] + (size_t)(l * 6 + h) * 465, scA, Y + (size_t)t * D + h * 128, 0.f, nullptr, 1.0f);
            continue;
        }
        idx -= N_AL;
        if (idx < N_M3) { m3_item(p, l, idx * 8 + wv); continue; }
        idx -= N_M3;
        if (idx < N_AC) {
            const int b = idx / 12, h = (idx % 12) / 2, qb = idx % 2;
            const int t = b * 256 + qb * 128 + wv * 16 + l16;
            const bf16_t* qrow = Qa + (size_t)t * 768 + h * 128;
            attn_block<false, false>(lds, qrow, qrow, Ka + (size_t)(b * 256) * 768 + h * 128, 768, 0, 4, VaT + (size_t)(b * 6 + h) * 128 * 256, 256,
                              nullptr, 0, 0, nullptr, 0, 0, 0, 0, 0, 0, nullptr, scA, Y + (size_t)t * D + h * 128, 0.f, nullptr, 1.0f);
            continue;
        }
        idx -= N_AC;
        {
            const int b = idx / 10, h = (idx % 10) / 2, qb = idx % 2;
            const int t = b * 256 + qb * 128 + wv * 16 + l16;
            const bf16_t* qrow = Qb + (size_t)t * 640 + h * 128;
            attn_block<true, false>(lds, qrow, qrow, Kb + (size_t)(b * 256) * 640 + h * 128, 640, 0, 4, VbT + (size_t)(b * 5 + h) * 128 * 256, 256,
                             nullptr, 0, 0, nullptr, 0, 0, 0, 0, 0, 0, nullptr, scB, Y + (size_t)t * D + 768 + h * 128, lam, subln, 1.0f - lam_init);
        }
    }
}

#define XB_TMO      128
#define XB_XCNT(j)  (256  + 64 * (j))
#define XB_XSUB(j)  (1280 + 64 * (j))
#define XB_XGEN(j)  (2304 + 64 * (j))
#define XB_TOP      3328
#define XB_TOPGEN   3392
#define XB_SPIN_CAP (1u << 18)
DEVI unsigned xb_ld(unsigned* p) { return __hip_atomic_load(p, __ATOMIC_RELAXED, __HIP_MEMORY_SCOPE_AGENT); }
DEVI unsigned xb_add(unsigned* p, unsigned v) { return __hip_atomic_fetch_add(p, v, __ATOMIC_RELAXED, __HIP_MEMORY_SCOPE_AGENT); }
DEVI unsigned xb_xcc_id() { return (unsigned)__builtin_amdgcn_s_getreg((3 << 11) | 20) & 0xFu; }
#define XB_SPIN(cond, bar) do { unsigned _sp = 0; while (cond) { __builtin_amdgcn_s_sleep(1); \
    if ((++_sp & 255u) == 0u) { if (xb_ld(&(bar)[XB_TMO])) break; if (_sp > XB_SPIN_CAP) { atomicAdd(&(bar)[XB_TMO], 1u); break; } } } } while (0)
struct XcdBarrier { unsigned* bar; unsigned x; volatile PG8_LAS unsigned* st; };
DEVI void xcd_barrier_complete(unsigned* bar, unsigned x, unsigned& nloc, unsigned& nx) {
    const unsigned G = gridDim.x;
    unsigned sum, cnt, mine, sp = 0u;
    for (;;) {
        sum = 0u; cnt = 0u; mine = 0u;
#pragma unroll
        for (unsigned j = 0; j < 16; ++j) { const unsigned c = xb_ld(&bar[XB_XCNT(j)]); sum += c; cnt += (c > 0u) ? 1u : 0u; mine = (j == x) ? c : mine; }
        if (sum == G) break;
        __builtin_amdgcn_s_sleep(1);
        if ((++sp & 255u) == 0u) { if (xb_ld(&bar[XB_TMO])) break; if (sp > XB_SPIN_CAP) { atomicAdd(&bar[XB_TMO], 1u); break; } }
    }
    nloc = mine > 0u ? mine : 1u; nx = cnt > 0u ? cnt : 1u;
}
DEVI void xcd_barrier(const XcdBarrier& b) {
    asm volatile("s_waitcnt vmcnt(0) lgkmcnt(0)" ::: "memory");
    __syncthreads();
    if (threadIdx.x == 0) {
        unsigned* bar = b.bar;
        __builtin_amdgcn_s_waitcnt(0);
        unsigned nloc = b.st[0], nx = b.st[1];
        if (nloc == 0u) { xcd_barrier_complete(bar, b.x, nloc, nx); b.st[0] = nloc; b.st[1] = nx; }
        const unsigned old = xb_add(&bar[XB_XSUB(b.x)], 1u);
        const unsigned gen = old / nloc;
        if (old + 1u == (gen + 1u) * nloc) {
            __builtin_amdgcn_fence(__ATOMIC_RELEASE, "agent");
            asm volatile("s_waitcnt vmcnt(0)" ::: "memory");
            const unsigned og = xb_add(&bar[XB_TOP], 1u);
            const unsigned tg = og / nx;
            if (og + 1u == (tg + 1u) * nx) xb_add(&bar[XB_TOPGEN], 1u);
            else XB_SPIN(xb_ld(&bar[XB_TOPGEN]) == tg, bar);
            __builtin_amdgcn_fence(__ATOMIC_ACQUIRE, "agent");
            xb_add(&bar[XB_XGEN(b.x)], 1u);
            asm volatile("s_waitcnt vmcnt(0)" ::: "memory");
        } else {
            XB_SPIN(xb_ld(&bar[XB_XGEN(b.x)]) == gen, bar);
            __builtin_amdgcn_fence(__ATOMIC_ACQUIRE, "agent");
            asm volatile("s_waitcnt vmcnt(0)" ::: "memory");
        }
    }
    __syncthreads();
}
#define gsync(G) xcd_barrier(xb)
constexpr int NPHASE = 19;
#ifndef PH_END
#define PH_END NPHASE
#endif
DEVI int kind_of_phase(int ph) {
    if (ph < 3) return ph;
    const int k = (ph - 3) % 8;
    return k == 0 ? 3 : k == 1 ? 4 : k == 2 ? 5 : k == 3 ? 6 : (k == 4 || k == 7) ? 7 : k == 5 ? 9 : 10;
}
template <unsigned MASK>
__global__ __launch_bounds__(512, 2) void fwd_kernel(P p) {
    extern __shared__ __attribute__((aligned(16))) unsigned char shm[];
    cg::grid_group grid = cg::this_grid();
    PG8_LAS unsigned char* lds = (PG8_LAS unsigned char*)shm;
    if (p.ph_lo < 0) grid.sync();
    volatile PG8_LAS unsigned* xst = (volatile PG8_LAS unsigned*)(lds + 131072);
    if (threadIdx.x == 0) { xst[0] = 0u; xst[1] = 0u; }
    __syncthreads();
    XcdBarrier xb; xb.bar = (unsigned*)(p.ws + W_BAR); xb.x = xb_xcc_id(); xb.st = xst;
    if (threadIdx.x == 0) (void)xb_add(&xb.bar[XB_XCNT(xb.x)], 1u);
#if PROBE
    unsigned long long* ts = (unsigned long long*)(p.ws + W_CNT + 2048);
    if (blockIdx.x == 0 && threadIdx.x == 0) ts[40] = wall_clock64();
    gsync(grid);
    if (blockIdx.x == 0 && threadIdx.x == 0) ts[41] = wall_clock64();
    gsync(grid);
    if (blockIdx.x == 0 && threadIdx.x == 0) ts[0] = wall_clock64();
#endif
    for (int ph = p.ph_lo; ph < p.ph_hi; ++ph) {
        char* ws = WSP(p.ws);
        const int kind = kind_of_phase(ph);
        const int l = ph < 3 ? 0 : (ph - 3) / 8, k = ph < 3 ? 0 : (ph - 3) % 8;
        const float* mods = (const float*)(ws + W_MODS) + (size_t)l * 36864;
        pg8::StaticOrder S;
        if constexpr ((MASK >> 0) & 1) if (kind == 0) phase0a(p, (float*)shm);
        if constexpr ((MASK >> 1) & 1) if (kind == 1) phase0b(p);
        if constexpr ((MASK >> 2) & 1) if (kind == 2) phase0c(p);
        if constexpr ((MASK >> 3) & 1) if (kind == 3) {
            pg8::Gemm g{(const bf16_t*)(ws + W_H), (const bf16_t*)(ws + W_WIN) + (size_t)l * NINP * D, T, NINP, D};
            S.init(T, NINP, (int)gridDim.x, (int)BIDX());
            EpiIn E{ws, p.out, p.in[I_GATEB], l};
            pg8::gemm_phase<EpiIn, pg8::StaticOrder>(lds, g, S, E);
            if ((int)BIDX() >= 96) weight_units(p, l, 280, 816, (int)BIDX() - 96, (int)gridDim.x - 96, (float*)shm);
        }
        if constexpr ((MASK >> 4) & 1) if (kind == 4) {
            for (int it = BIDX() * 8 + (TIDX() >> 6); it < 1280; it += gridDim.x * 8) m1_item(p, it);
        }
        if constexpr ((MASK >> 5) & 1) if (kind == 5) m2_phase(p, l);
        if constexpr ((MASK >> 6) & 1) if (kind == 6) mixer_phase(p, l, lds);
        if constexpr ((MASK >> 7) & 1) if (kind == 7) {
            float* stats = (float*)(ws + W_MODP);
            unsigned* lncnt = (unsigned*)(ws + W_CNT) + 256;
            const bool last = l == 1;
            if (k == 4) {
                pg8::Gemm g{(const bf16_t*)(ws + W_Y), (const bf16_t*)(ws + W_WOUT) + (size_t)l * D * D, T, D, D};
                S.init(T, D, (int)gridDim.x, (int)BIDX());
                EpiResLN E{l == 0 ? p.in[I_XP] : (const float*)(ws + W_X), l == 0 ? p.in[I_XS] : (const float*)(ws + W_X) + (size_t)TC * XS, (float*)(ws + W_X), mods + 2 * 2048,
                           p.in[I_LN1G] + l * D, p.in[I_LN1B] + l * D, mods + 3 * 2048, (bf16_t*)(ws + W_H), stats + (size_t)(l * 2) * 32 * 256 * 16, lncnt + (l * 2) * 32, l == 0 ? D : XS, XS};
                pg8::gemm_phase<EpiResLN, pg8::StaticOrder>(lds, g, S, E);
            } else {
                pg8::Gemm g{(const bf16_t*)(ws + W_ACT), (const bf16_t*)(ws + W_WDN) + (size_t)l * D * DFF, T, D, DFF};
                S.init(T, D, (int)gridDim.x, (int)BIDX());
                EpiResLN E{(const float*)(ws + W_X), (const float*)(ws + W_X) + (size_t)TC * XS, last ? p.out + O_Y : (float*)(ws + W_X), mods + 5 * 2048,
                           p.in[I_LN2G] + l * D, p.in[I_LN2B] + l * D, last ? nullptr : mods + 36864, (bf16_t*)(ws + W_H), stats + (size_t)(l * 2 + 1) * 32 * 256 * 16, lncnt + (l * 2 + 1) * 32, XS, last ? D : XS};
                pg8::gemm_phase<EpiResLN, pg8::StaticOrder>(lds, g, S, E);
            }
        }
        if constexpr ((MASK >> 9) & 1) if (kind == 9) {
            pg8::Gemm g{(const bf16_t*)(ws + W_H), (const bf16_t*)(ws + W_WUP) + (size_t)l * NUP * D, T, NUP, D};
            S.init(T, NUP, (int)gridDim.x, (int)BIDX());
            EpiU E{(bf16_t*)(ws + W_U)};
            pg8::gemm_phase<EpiU, pg8::StaticOrder>(lds, g, S, E);
            if (l == 0 && (int)BIDX() >= 96) weight_units(p, 1, 0, 280, (int)BIDX() - 96, (int)gridDim.x - 96, (float*)shm);
        }
        if constexpr ((MASK >> 10) & 1) if (kind == 10) conv_phase(p, l);
#if PROBE
        gsync(grid);
        if (blockIdx.x == 0 && threadIdx.x == 0) ts[ph + 1] = wall_clock64();
#else
        if (ph + 1 < p.ph_hi) gsync(grid);
#endif
    }
#if CMP
    gsync(grid);
    if (blockIdx.x == 0) {
        const unsigned* cw = (const unsigned*)(p.ws + W_CNT);
        const size_t offs[8] = {O_Y, O_Y + 8388608, O_AK, O_AV, O_BK, O_BV, O_CC, O_CN};
        for (int c = 0; c < 8; ++c) {
            const unsigned m = __hip_atomic_load(cw + 128 + c, __ATOMIC_RELAXED, __HIP_MEMORY_SCOPE_AGENT);
            const int n = m == 0 ? 0 : (m < 1000 ? 10 : (m < 20000 ? 100 : 1000));
            unsigned* o = (unsigned*)p.out + offs[c];
            for (int i = threadIdx.x; i < n; i += 512) o[i] = 0xAAAAAAAAu;
        }
    }
#endif
#if PROBE
    if (blockIdx.x == 0) {
        __syncthreads();
        const size_t offs[9] = {O_Y, O_Y + 8388608, O_AK, O_AV, O_BK, O_BV, O_CC, O_CN, O_CM};
#if PROBE == 1
        const int ta[9] = {0, 3, 4, 6, 7, 8, 9, 0, 0}, tb[9] = {3, 4, 6, 7, 8, 9, 10, 0, 0};
        const int dv[9] = {400, 400, 400, 400, 400, 400, 400, 100, 100};
#elif PROBE == 4
        const int ta[9] = {3, 4, 6, 7, 8, 9, 10, 0, 0}, tb[9] = {4, 6, 7, 8, 9, 10, 11, 0, 0};
        const int dv[9] = {400, 400, 400, 400, 400, 400, 400, 100, 100};
#elif PROBE == 5
        const int ta[9] = {0, 45, 1, 2, 4, 5, 9, 0, 0}, tb[9] = {45, 1, 2, 3, 5, 6, 10, 0, 0};
        const int dv[9] = {400, 400, 400, 400, 400, 400, 400, 100, 100};
#elif PROBE == 3
        const int ta[9] = {10, 11, 12, 0, 1, 2, 5, 0, 0}, tb[9] = {11, 12, 13, 1, 2, 3, 6, 0, 0};
        const int dv[9] = {400, 400, 400, 400, 400, 400, 400, 100, 100};
#else
        const int ta[9] = {40, 0, 4, 5, 6, 6, 6, 0, 0}, tb[9] = {41, 1, 5, 6, 42, 43, 44, 0, 0};
        const int dv[9] = {40, 400, 400, 400, 400, 400, 400, 100, 100};
#endif
        for (int c = 0; c < 9; ++c) {
            long long d = (long long)(ts[tb[c]] - ts[ta[c]]) / dv[c];
            int n = (int)d; if (c == 8 && n > 320) n = 320; if (c == 7 && n > 40960) n = 40960;
            unsigned* o = (unsigned*)p.out + offs[c];
            for (int i = threadIdx.x; i < n; i += 512) o[i] = 0xAAAAAAAAu;
        }
    }
#endif
}

static int host_kind_of_phase(int ph) {
    if (ph < 3) return ph;
    const int k = (ph - 3) % 8;
    return k == 0 ? 3 : k == 1 ? 4 : k == 2 ? 5 : k == 3 ? 6 : (k == 4 || k == 7) ? 7 : k == 5 ? 9 : 10;
}
typedef void (*kern_t)(P);
extern "C" void kernel_launch(void* const* d_in, const int* in_sizes, int n_in, void* d_out, int out_size, void* d_ws, size_t ws_size, hipStream_t stream) {
    constexpr size_t kDynLds = 131072 + 16;
    static int grid_blocks = 0;
#if ONE_LAUNCH
    static kern_t kerns[1] = {fwd_kernel<0x7ffu>};
    constexpr int NK = 1;
#else
    static kern_t kerns[11] = {fwd_kernel<1u>, fwd_kernel<2u>, fwd_kernel<4u>, fwd_kernel<8u>, fwd_kernel<16u>, fwd_kernel<32u>, fwd_kernel<64u>, fwd_kernel<128u>, fwd_kernel<256u>, fwd_kernel<512u>, fwd_kernel<1024u>};
    constexpr int NK = 11;
#endif
    if (!grid_blocks) {
        int dev = 0, cus = 0, per_cu = 8;
        (void)hipGetDevice(&dev);
        (void)hipDeviceGetAttribute(&cus, hipDeviceAttributeMultiprocessorCount, dev);
        for (int i = 0; i < NK; ++i) {
            int pc = 0;
            (void)hipFuncSetAttribute((const void*)kerns[i], hipFuncAttributeMaxDynamicSharedMemorySize, (int)kDynLds);
            (void)hipOccupancyMaxActiveBlocksPerMultiprocessor(&pc, kerns[i], 512, kDynLds);
            if (pc < per_cu) per_cu = pc;
        }
        if (per_cu < 1) per_cu = 1;
        grid_blocks = cus * per_cu;
        if (ws_size < W_END) fprintf(stderr, "workspace too small: %zu < %zu\n", ws_size, (size_t)W_END);
    }
    P p{};
    for (int i = 0; i < 28; ++i) p.in[i] = (const float*)d_in[i];
    p.out = (float*)d_out;
    p.ws = (char*)d_ws;
    (void)hipMemsetAsync((char*)d_ws + W_CNT, 0, 22528, stream);
#if ONE_LAUNCH
    p.ph_lo = 0; p.ph_hi = NPHASE;
    void* args[] = {&p};
    hipError_t e = hipLaunchCooperativeKernel((const void*)kerns[0], dim3(grid_blocks), dim3(512), args, kDynLds, stream);
    if (e != hipSuccess) fprintf(stderr, "cooperative launch failed: %s (grid %d)\n", hipGetErrorString(e), grid_blocks);
#else
    for (int ph = 0; ph < PH_END; ++ph) {
        p.ph_lo = ph; p.ph_hi = ph + 1;
        hipLaunchKernelGGL(kerns[host_kind_of_phase(ph)], dim3(grid_blocks), dim3(512), kDynLds, stream, p);
    }
#endif
}
```

```cpp
#include <hip/hip_runtime.h>
#include <hip/hip_cooperative_groups.h>
#include <cstdio>
namespace cg = cooperative_groups;

#define DEVI __device__ __forceinline__
typedef unsigned short bf16_t;
typedef short bf16x8 __attribute__((ext_vector_type(8)));
typedef float f32x4 __attribute__((ext_vector_type(4)));
typedef unsigned u32x4 __attribute__((ext_vector_type(4)));
typedef unsigned u32x2 __attribute__((ext_vector_type(2)));

constexpr int D = 2048, T = 8192, TC = 4096, NIN = 6804, NINP = 6912, DFF = 5504, NUP = 11008;
constexpr float ALPHA = 1.4142135623730951f;
constexpr float LOG2E = 1.4426950408889634f;

constexpr size_t O_Y = 0, O_AK = 16777216, O_AV = 23068672, O_BK = 29360128, O_BV = 34603008, O_CC = 39845888, O_CN = 45088768, O_CM = 45129728;

constexpr size_t al256(size_t x) { return (x + 255) & ~(size_t)255; }
constexpr size_t W_CNT = 0;
constexpr size_t W_BAR = 8192;
constexpr size_t W_WIN = 32768;
constexpr size_t W_WOUT = W_WIN + (size_t)2 * NINP * D * 2;
constexpr size_t W_WUP = W_WOUT + (size_t)2 * D * D * 2;
constexpr size_t W_WDN = W_WUP + (size_t)2 * NUP * D * 2;
constexpr size_t W_MODP = W_WDN + (size_t)2 * D * DFF * 2;
constexpr size_t W_MODS = W_MODP + (size_t)2 * 16 * 3 * 12288 * 4;
constexpr size_t W_ROPE = W_MODS + (size_t)2 * 3 * 12288 * 4;
constexpr size_t W_CKA = W_ROPE + 8192;
constexpr size_t W_CVA = W_CKA + (size_t)24 * 65536 * 2;
constexpr size_t W_CKB = W_CVA + (size_t)24 * 65536 * 2;
constexpr size_t W_CVB = W_CKB + (size_t)20 * 65536 * 2;
constexpr size_t W_X = W_CVB + (size_t)20 * 65536 * 2;
constexpr int XS = 2112;
constexpr size_t W_H = W_X + (size_t)T * XS * 4;
constexpr size_t W_R = W_H + (size_t)T * D * 2;
constexpr size_t SZA = (size_t)T * 768 * 2, SZB = (size_t)T * 640 * 2;
constexpr size_t W_QA = W_R, W_KA = W_QA + SZA, W_VAT = W_KA + SZA;
constexpr size_t W_QB = W_VAT + SZA, W_QBR = W_QB + SZB, W_KB = W_QBR + SZB / 2, W_VBT = W_KB + SZB;
constexpr size_t W_QC = W_VBT + SZB, W_KC = W_QC + SZB, W_KCT = W_KC + SZB, W_VCT = W_KCT + SZB, W_OG = W_VCT + SZB;
constexpr size_t W_G = W_OG + SZB;
constexpr size_t W_Y = W_G + (size_t)T * 20 * 4;
constexpr size_t W_ST = W_Y + (size_t)T * D * 2;
constexpr size_t W_SN = W_ST + (size_t)1920 * 16384 * 4;
constexpr size_t W_SS = W_SN + (size_t)1920 * 128 * 4;
constexpr size_t W_REND = W_SS + (size_t)3 * 1920 * 4;
constexpr size_t W_MODP2 = W_R;
constexpr size_t W_U = W_R;
constexpr size_t W_UEND = W_U + (size_t)T * NUP * 2;
constexpr size_t W_ACT = al256(W_REND > W_UEND ? W_REND : W_UEND);
constexpr size_t W_END = W_ACT + (size_t)T * DFF * 2;

struct P {
    const float* in[28];
    float* out;
    char* ws;
    int ph_lo, ph_hi;
};
enum { I_XP = 0, I_XS, I_CAK, I_CAV, I_CBK, I_CBV, I_SC, I_SN, I_SM, I_C, I_CCTX, I_WMOD, I_BMOD, I_WIN, I_GATEB, I_RPB, I_LAMBDA, I_SUBLN, I_CNORM, I_WOUT,
       I_LN1G, I_LN1B, I_LN2G, I_LN2B, I_WUP, I_CONVW, I_CONVB, I_WDN };

DEVI float bf2f(bf16_t v) { return __uint_as_float(((unsigned)v) << 16); }
DEVI float bflo(unsigned u) { return __uint_as_float(u << 16); }
DEVI float bfhi(unsigned u) { return __uint_as_float(u & 0xffff0000u); }
DEVI float wave_sum(float v) {
#pragma unroll
    for (int o = 32; o > 0; o >>= 1) v += __shfl_xor(v, o);
    return v;
}
DEVI float wave_max(float v) {
#pragma unroll
    for (int o = 32; o > 0; o >>= 1) v = fmaxf(v, __shfl_xor(v, o));
    return v;
}
DEVI float sigmoidf_(float x) { return __builtin_amdgcn_rcpf(1.0f + __expf(-x)); }
DEVI float siluf_(float x) { return x * __builtin_amdgcn_rcpf(1.0f + __expf(-x)); }

DEVI int TIDX() { int t = threadIdx.x; asm volatile("" : "+v"(t)); return t; }
DEVI int BIDX() { int b = blockIdx.x; asm volatile("" : "+s"(b)); return b; }
DEVI char* WSP(char* w) { asm volatile("" : "+s"(w)); return w; }
#define ONE_LAUNCH 1
namespace pg8 {
#define PG8_LAS __attribute__((address_space(3)))
typedef unsigned short bf16_t;
typedef short bf16x8 __attribute__((ext_vector_type(8)));
typedef float f32x4 __attribute__((ext_vector_type(4)));
typedef unsigned u32x4 __attribute__((ext_vector_type(4)));
constexpr int BM = 256, BK = 64, HALF = 128, HTB = HALF * BK * 2  , STAGE_BYTES = 8 * HTB, NXCD = 8, WGM = 8;

__host__ __device__ __forceinline__ int lds_byte(int r, int c) { const int st = (r >> 4) * 2 + (c >> 5), rr = r & 15, cc = c & 31, ob = rr * 64 + cc * 2; return st * 1024 + (ob ^ (((ob >> 9) & 1) << 5)); }
__host__ __device__ __forceinline__ void stage_rc(int b, int& R, int& C) { const int st = b / 1024, sb = b % 1024, swz = sb ^ (((sb >> 9) & 1) << 5); R = (st >> 1) * 16 + swz / 64; C = (st & 1) * 32 + (swz % 64) / 2; }
__host__ __device__ __forceinline__ int perm32(int rho) { const int n = rho >> 4, i = rho & 15; return 8 * (i >> 2) + 4 * n + (i & 3); }

struct Unit { int pm, pn; };
struct Gemm { const bf16_t* A; const bf16_t* Bt; int M, N, K; };

struct StaticOrder {
    int nM, nN, nwg, G, c;
    __host__ __device__ __forceinline__ void init(int M, int N, int G_, int c_) { nM = M / BM; nN = N / BM; nwg = nM * nN; G = G_; c = c_; }
    __host__ __device__ __forceinline__ bool next(int i, Unit& u) const {
        const long L = (long)i * G + c; if (L >= nwg) return false;
        int wgid = (int)L; { const int q = nwg / NXCD, r = nwg % NXCD, xcd = wgid % NXCD, off = wgid / NXCD; wgid = (xcd < r ? xcd * (q + 1) : r * (q + 1) + (xcd - r) * q) + off; }
        const int nig = WGM * nN, gid = wgid / nig, fm = gid * WGM, gsz = (nM - fm) < WGM ? (nM - fm) : WGM;
        u.pm = fm + ((wgid % nig) % gsz); u.pn = (wgid % nig) / gsz; return true;
    }
    __device__ __forceinline__ void a_ready(const Unit&) const {}
    __device__ __forceinline__ void done(const Unit&) const {}
};
__device__ __forceinline__ unsigned cvt_pk_bf16(float lo, float hi) { unsigned r; asm volatile("v_cvt_pk_bf16_f32 %0, %1, %2" : "=v"(r) : "v"(lo), "v"(hi)); return r; }
template <class Epi, class Sched>
__device__ __forceinline__ void gemm_phase(PG8_LAS unsigned char* lds, const Gemm g, const Sched& S, const Epi& E) {
    const int tid = TIDX(), wid = __builtin_amdgcn_readfirstlane(tid >> 6), lane = tid & 63, wr = wid >> 2, wc = wid & 3, fr = lane & 15, fq = lane >> 4;
    const int K = g.K, nt = K / BK;
    unsigned voffA[2], voffB[2];
#pragma unroll
    for (int i = 0; i < 2; ++i) { int R, C; stage_rc(tid * 16 + i * 8192, R, C); const int Rb = Epi::PERM ? ((R & ~31) + perm32(R & 31)) : R;
        voffA[i] = (unsigned)(R * K + C) * 2u; voffB[i] = (unsigned)(Rb * K + C) * 2u; }
    const size_t kstep = (size_t)(BK * 2);
    const size_t hstep = (size_t)HALF * K * 2;
    const size_t tstep = 2 * hstep;
    const unsigned ldsw = (unsigned)wid * 1024u;
    const int aoff = lds_byte(wr * 64 + fr, fq * 8), boff = lds_byte(wc * 32 + fr, fq * 8);
#define PG8_SA(b, h) (((b) * 2 + (h)) * HTB)
#define PG8_SB(b, h) ((4 + (b) * 2 + (h)) * HTB)
#define PG8_STAGE(bufoff, gbase, voff) do { _Pragma("unroll") for (int _i = 0; _i < 2; ++_i) \
        __builtin_amdgcn_global_load_lds((const unsigned*)((const char*)(gbase) + (voff)[_i]), (PG8_LAS unsigned*)(lds + (bufoff) + ldsw + _i * 8192), 16, 0, 0); } while (0)
#define PG8_LDA(dst, b, h) do { _Pragma("unroll") for (int m = 0; m < 4; ++m) _Pragma("unroll") for (int k = 0; k < 2; ++k) dst[m][k] = *(const PG8_LAS bf16x8*)(lds + PG8_SA(b, h) + aoff + m * 2048 + k * 1024); } while (0)
#define PG8_LDB(dst, b, h) do { _Pragma("unroll") for (int n = 0; n < 2; ++n) _Pragma("unroll") for (int k = 0; k < 2; ++k) dst[n][k] = *(const PG8_LAS bf16x8*)(lds + PG8_SB(b, h) + boff + n * 2048 + k * 1024); } while (0)
#define PG8_MMA(ai, bj, At, Bt) do { __builtin_amdgcn_s_setprio(1); _Pragma("unroll") for (int m = 0; m < 4; ++m) _Pragma("unroll") for (int n = 0; n < 2; ++n) _Pragma("unroll") for (int k = 0; k < 2; ++k) \
        acc[ai][bj][m][n] = __builtin_amdgcn_mfma_f32_16x16x32_bf16(Bt[n][k], At[m][k], acc[ai][bj][m][n], 0, 0, 0); __builtin_amdgcn_s_setprio(0); } while (0)
#define PG8_WAIT_V(n) asm volatile("s_waitcnt vmcnt(" #n ")" ::: "memory")
#define PG8_WAIT_L(n) asm volatile("s_waitcnt lgkmcnt(" #n ")" ::: "memory")
#define PG8_BAR __builtin_amdgcn_s_barrier()
#define PG8_SCHED __builtin_amdgcn_sched_barrier(0)
    Unit cur, nxt; int ui = 0;
    if (!S.next(0, cur)) return;
    f32x4 acc[2][2][4][2];
#pragma unroll
    for (int a = 0; a < 2; ++a)
#pragma unroll
        for (int b = 0; b < 2; ++b)
#pragma unroll
            for (int m = 0; m < 4; ++m)
#pragma unroll
                for (int n = 0; n < 2; ++n) acc[a][b][m][n] = (f32x4){0.f, 0.f, 0.f, 0.f};
    bf16x8 At[4][2], B0[2][2], B1[2][2];
    const char* cA = (const char*)g.A + (size_t)cur.pm * tstep; const char* cB = (const char*)g.Bt + (size_t)cur.pn * tstep;
    S.a_ready(cur);
    PG8_STAGE(PG8_SB(0, 0), cB, voffB); PG8_STAGE(PG8_SA(0, 0), cA, voffA); PG8_STAGE(PG8_SB(0, 1), cB + hstep, voffB); PG8_STAGE(PG8_SA(0, 1), cA + hstep, voffA);
    if (wr == 1) PG8_BAR;
    PG8_WAIT_V(4); PG8_BAR;
    PG8_STAGE(PG8_SB(1, 0), cB + kstep, voffB); PG8_STAGE(PG8_SA(1, 0), cA + kstep, voffA); PG8_STAGE(PG8_SB(1, 1), cB + hstep + kstep, voffB);
    PG8_WAIT_V(6); PG8_BAR;
    for (;;) {
        const bool has_next = S.next(ui + 1, nxt);
        const char* nA = has_next ? (const char*)g.A + (size_t)nxt.pm * tstep : cA; const char* nB = has_next ? (const char*)g.Bt + (size_t)nxt.pn * tstep : cB;
        for (int t = 0; t < nt; t += 2) {
            const bool last = (t == nt - 2);
            const char* a1 = cA + (size_t)(t + 1) * kstep;
            const char* a2 = last ? nA : cA + (size_t)(t + 2) * kstep; const char* b2 = last ? nB : cB + (size_t)(t + 2) * kstep;
            const char* a3 = a2 + kstep; const char* b3 = b2 + kstep;
            if (last && has_next) S.a_ready(nxt);
            PG8_LDB(B0, 0, 0); PG8_SCHED; PG8_LDA(At, 0, 0); PG8_STAGE(PG8_SA(1, 1), a1 + hstep, voffA);
            PG8_WAIT_L(8); PG8_BAR; PG8_WAIT_L(0); PG8_MMA(0, 0, At, B0); PG8_BAR; PG8_SCHED;
            PG8_LDB(B1, 0, 1); PG8_STAGE(PG8_SB(0, 0), b2, voffB);
            PG8_BAR; PG8_WAIT_L(0); PG8_MMA(0, 1, At, B1); PG8_BAR;
            PG8_LDA(At, 0, 1); PG8_STAGE(PG8_SA(0, 0), a2, voffA);
            PG8_BAR; PG8_WAIT_L(0); PG8_MMA(1, 0, At, B0); PG8_BAR; PG8_SCHED;
            PG8_STAGE(PG8_SB(0, 1), b2 + hstep, voffB);
            PG8_WAIT_V(6); PG8_BAR; PG8_MMA(1, 1, At, B1); PG8_BAR;
            PG8_LDB(B0, 1, 0); PG8_SCHED; PG8_LDA(At, 1, 0); PG8_STAGE(PG8_SA(0, 1), a2 + hstep, voffA);
            PG8_WAIT_L(8); PG8_BAR; PG8_WAIT_L(0); PG8_MMA(0, 0, At, B0); PG8_BAR; PG8_SCHED;
            PG8_LDB(B1, 1, 1); PG8_STAGE(PG8_SB(1, 0), b3, voffB);
            PG8_BAR; PG8_WAIT_L(0); PG8_MMA(0, 1, At, B1); PG8_BAR;
            PG8_LDA(At, 1, 1); PG8_STAGE(PG8_SA(1, 0), a3, voffA);
            PG8_BAR; PG8_WAIT_L(0); PG8_MMA(1, 0, At, B0); PG8_BAR; PG8_SCHED;
            PG8_STAGE(PG8_SB(1, 1), b3 + hstep, voffB);
            PG8_WAIT_V(6); PG8_BAR; PG8_MMA(1, 1, At, B1); PG8_BAR;
        }
        if constexpr (!Epi::AFTER_DRAIN) { E(acc, cur, wr, wc, fr, fq); S.done(cur); }
        if (!has_next) break;
#pragma unroll
        for (int a = 0; a < 2; ++a)
#pragma unroll
            for (int b = 0; b < 2; ++b)
#pragma unroll
                for (int m = 0; m < 4; ++m)
#pragma unroll
                    for (int n = 0; n < 2; ++n) acc[a][b][m][n] = (f32x4){0.f, 0.f, 0.f, 0.f};
        cur = nxt; cA = nA; cB = nB; ++ui;
    }
    PG8_WAIT_V(0);
    if (wr == 0) PG8_BAR;
    PG8_BAR;
    if constexpr (Epi::AFTER_DRAIN) { E.fused(acc, cur, wr, wc, fr, fq, lds, wid, lane); S.done(cur); }
#undef PG8_SA
#undef PG8_SB
#undef PG8_STAGE
#undef PG8_LDA
#undef PG8_LDB
#undef PG8_MMA
#undef PG8_WAIT_V
#undef PG8_WAIT_L
#undef PG8_BAR
#undef PG8_SCHED
}
}

using pg8::cvt_pk_bf16;
DEVI bf16x8 ld8(const bf16_t* p) { return *(const bf16x8*)p; }
DEVI bf16x8 ld4x2(const bf16_t* p0, const bf16_t* p1) {
    const u32x2 a = *(const u32x2*)p0, b = *(const u32x2*)p1;
    const u32x4 r = {a[0], a[1], b[0], b[1]};
    return __builtin_bit_cast(bf16x8, r);
}
DEVI bf16x8 pack8(f32x4 a, f32x4 b) {
    const u32x4 r = {cvt_pk_bf16(a[0], a[1]), cvt_pk_bf16(a[2], a[3]), cvt_pk_bf16(b[0], b[1]), cvt_pk_bf16(b[2], b[3])};
    return __builtin_bit_cast(bf16x8, r);
}
DEVI void st4(bf16_t* p, f32x4 v) { const u32x2 r = {cvt_pk_bf16(v[0], v[1]), cvt_pk_bf16(v[2], v[3])}; *(u32x2*)p = r; }
DEVI bf16_t f2bf1(float f) { return (bf16_t)(cvt_pk_bf16(f, 0.f) & 0xffffu); }
DEVI f32x4 mfma16(bf16x8 a, bf16x8 b, f32x4 c) { return __builtin_amdgcn_mfma_f32_16x16x32_bf16(a, b, c, 0, 0, 0); }
DEVI float ex2(float x) { return __builtin_amdgcn_exp2f(x); }
DEVI int clampi(int v, int lo, int hi) { return v < lo ? lo : (v > hi ? hi : v); }
DEVI int cond_of_row(int t) { return t < TC ? 0 : 1 + ((t - TC) >> 11); }

DEVI void transpose_tile(const float* __restrict__ W, bf16_t* __restrict__ Wt, int K, int N, int tk, int tn, float* sm) {
    const int tid = TIDX();
#pragma unroll
    for (int p = 0; p < 2; ++p) {
        const int kr = p * 32 + (tid >> 4), nc = (tid & 15) * 4;
        const int gk = tk * 64 + kr, gn = tn * 64 + nc;
        f32x4 v = {0.f, 0.f, 0.f, 0.f};
        if (gn < N) v = *(const f32x4*)(W + (size_t)gk * N + gn);
        sm[kr * 65 + nc + 0] = v[0]; sm[kr * 65 + nc + 1] = v[1]; sm[kr * 65 + nc + 2] = v[2]; sm[kr * 65 + nc + 3] = v[3];
    }
    __syncthreads();
    const int n = tid >> 3, kg = tid & 7;
    float f[8];
#pragma unroll
    for (int j = 0; j < 8; ++j) f[j] = sm[(kg * 8 + j) * 65 + n];
    const u32x4 o = {cvt_pk_bf16(f[0], f[1]), cvt_pk_bf16(f[2], f[3]), cvt_pk_bf16(f[4], f[5]), cvt_pk_bf16(f[6], f[7])};
    *(u32x4*)(Wt + (size_t)(tn * 64 + n) * K + tk * 64 + kg * 8) = o;
    __syncthreads();
}
DEVI void conv_T(const float* W, bf16_t* Wt, int K, int N, int Npad, int nmat, int rot, float* sm) {
    const int tkn = K / 64, tnn = Npad / 64, per = tkn * tnn, total = per * nmat;
    const int start = (int)((BIDX() + gridDim.x - (rot % gridDim.x)) % gridDim.x);
    for (int t = start; t < total; t += gridDim.x) {
        const int mat = t / per, r = t % per, tk = r / tnn, tn = r % tnn;
        transpose_tile(W + (size_t)mat * K * N, Wt + (size_t)mat * Npad * K, K, N, tk, tn, sm);
    }
}
DEVI void conv_T2_unit(const float* __restrict__ W, bf16_t* __restrict__ Wt, int K, int N, int Npad, int u, int tid) {
    const int nbn = (Npad + 2047) / 2048;
    const int kb = u / nbn, nb = u % nbn;
    const int n = nb * 2048 + tid * 4;
    if (n >= Npad) return;
    f32x4 r[16];
    const float* src = W + (size_t)(kb * 16) * N + n;
#pragma unroll
    for (int j = 0; j < 16; ++j) r[j] = n < N ? __builtin_nontemporal_load((const f32x4*)(src + (size_t)j * N)) : (f32x4){0.f, 0.f, 0.f, 0.f};
#pragma unroll
    for (int i = 0; i < 4; ++i) {
        const u32x4 lo = {cvt_pk_bf16(r[0][i], r[1][i]), cvt_pk_bf16(r[2][i], r[3][i]), cvt_pk_bf16(r[4][i], r[5][i]), cvt_pk_bf16(r[6][i], r[7][i])};
        const u32x4 hi = {cvt_pk_bf16(r[8][i], r[9][i]), cvt_pk_bf16(r[10][i], r[11][i]), cvt_pk_bf16(r[12][i], r[13][i]), cvt_pk_bf16(r[14][i], r[15][i])};
        bf16_t* d = Wt + (size_t)(n + i) * K + kb * 16;
        *(u32x4*)d = lo; *(u32x4*)(d + 8) = hi;
    }
}
DEVI void conv_T3_unit(const float* __restrict__ W, bf16_t* __restrict__ Wt, int K, int N, int tn, int tk0, int ntk, int rot, float* sm, int tid) {
    const int kr = tid >> 4, nc = (tid & 15) * 4, gn = tn * 64 + nc;
    const int n = tid >> 3, kg = tid & 7;
    const bool inb = gn < N;
    f32x4 v0 = {0.f, 0.f, 0.f, 0.f}, v1 = v0;
    { const int tk = tk0 + (rot % ntk);
      if (inb) { v0 = __builtin_nontemporal_load((const f32x4*)(W + (size_t)(tk * 64 + kr) * N + gn)); v1 = __builtin_nontemporal_load((const f32x4*)(W + (size_t)(tk * 64 + 32 + kr) * N + gn)); } }
    for (int i = 0; i < ntk; ++i) {
        const int tk = tk0 + ((rot + i) % ntk);
        sm[kr * 65 + nc + 0] = v0[0]; sm[kr * 65 + nc + 1] = v0[1]; sm[kr * 65 + nc + 2] = v0[2]; sm[kr * 65 + nc + 3] = v0[3];
        sm[(32 + kr) * 65 + nc + 0] = v1[0]; sm[(32 + kr) * 65 + nc + 1] = v1[1]; sm[(32 + kr) * 65 + nc + 2] = v1[2]; sm[(32 + kr) * 65 + nc + 3] = v1[3];
        if (i + 1 < ntk && inb) {
            const int tk2 = tk0 + ((rot + i + 1) % ntk);
            v0 = __builtin_nontemporal_load((const f32x4*)(W + (size_t)(tk2 * 64 + kr) * N + gn)); v1 = __builtin_nontemporal_load((const f32x4*)(W + (size_t)(tk2 * 64 + 32 + kr) * N + gn));
        }
        __syncthreads();
        float f[8];
#pragma unroll
        for (int j = 0; j < 8; ++j) f[j] = sm[(kg * 8 + j) * 65 + n];
        const u32x4 o = {cvt_pk_bf16(f[0], f[1]), cvt_pk_bf16(f[2], f[3]), cvt_pk_bf16(f[4], f[5]), cvt_pk_bf16(f[6], f[7])};
        *(u32x4*)(Wt + (size_t)(tn * 64 + n) * K + tk * 64 + kg * 8) = o;
        __syncthreads();
    }
}
DEVI void conv_plain(const float* __restrict__ src, bf16_t* __restrict__ dst, size_t n4) {
    const size_t nthr = (size_t)gridDim.x * 512;
    for (size_t i0 = (size_t)BIDX() * 512 + TIDX(); i0 < n4; i0 += 4 * nthr) {
        f32x4 v[4];
#pragma unroll
        for (int u = 0; u < 4; ++u) { const size_t i = i0 + u * nthr; if (i < n4) v[u] = __builtin_nontemporal_load((const f32x4*)(src + i * 4)); }
#pragma unroll
        for (int u = 0; u < 4; ++u) { const size_t i = i0 + u * nthr; if (i < n4) st4(dst + i * 4, v[u]); }
    }
}
DEVI void weight_units(const P& p, int l, int u0, int u1, int w, int nw, float* sm) {
    const int tid = TIDX();
    char* ws = WSP(p.ws);
    const int rot = w & 15;
    for (int u = u0 + w; u < u1; u += nw) {
        int v = u;
        if (v < 216) conv_T3_unit(p.in[I_WIN] + (size_t)l * D * NIN, (bf16_t*)(ws + W_WIN) + (size_t)l * NINP * D, D, NIN, v >> 1, (v & 1) * 16, 16, rot, sm, tid);
        else if ((v -= 216) < 64) conv_T3_unit(p.in[I_WOUT] + (size_t)l * D * D, (bf16_t*)(ws + W_WOUT) + (size_t)l * D * D, D, D, v >> 1, (v & 1) * 16, 16, rot, sm, tid);
        else if ((v -= 64) < 344) conv_T3_unit(p.in[I_WUP] + (size_t)l * D * NUP, (bf16_t*)(ws + W_WUP) + (size_t)l * NUP * D, D, NUP, v >> 1, (v & 1) * 16, 16, rot, sm, tid);
        else { v -= 344; const int part = v % 6; conv_T3_unit(p.in[I_WDN] + (size_t)l * DFF * D, (bf16_t*)(ws + W_WDN) + (size_t)l * D * DFF, DFF, D, v / 6, part * 16, part == 5 ? 6 : 16, rot, sm, tid); }
    }
}
DEVI void phase0a(const P& p, float* sm) {
    const int tid = TIDX();
    char* ws = WSP(p.ws);
    for (int it = BIDX(); it < 768; it += gridDim.x) {
        const int l = it / 384, kc = (it % 384) / 6, jb = it % 6;
        if (tid < 96) { const int ci = tid >> 5, k = kc * 32 + (tid & 31); const float cv = ci == 0 ? p.in[I_CCTX][k] : p.in[I_C][(ci - 1) * D + k]; sm[tid] = siluf_(cv); }
        __syncthreads();
        const int j = jb * 2048 + tid * 4;
        f32x4 a0 = {0.f, 0.f, 0.f, 0.f}, a1 = a0, a2 = a0;
        const float* wp = p.in[I_WMOD] + ((size_t)l * D + kc * 32) * 12288 + j;
#pragma unroll
        for (int h2 = 0; h2 < 2; ++h2) {
            f32x4 w[16];
#pragma unroll
            for (int kk = 0; kk < 16; ++kk) w[kk] = __builtin_nontemporal_load((const f32x4*)(wp + (size_t)(h2 * 16 + kk) * 12288));
#pragma unroll
            for (int kk = 0; kk < 16; ++kk) { a0 += sm[h2 * 16 + kk] * w[kk]; a1 += sm[32 + h2 * 16 + kk] * w[kk]; a2 += sm[64 + h2 * 16 + kk] * w[kk]; }
        }
        float* mp = (float*)(ws + W_MODP2) + ((size_t)(l * 64 + kc) * 3) * 12288 + j;
        *(f32x4*)(mp) = a0; *(f32x4*)(mp + 12288) = a1; *(f32x4*)(mp + 2 * 12288) = a2;
        __syncthreads();
    }
#if PROBE
    if (blockIdx.x == 0 && threadIdx.x == 0) ((unsigned long long*)(p.ws + W_CNT + 2048))[45] = wall_clock64();
#endif
    if (BIDX() == gridDim.x - 1) {
        float* rt = (float*)(ws + W_ROPE);
        for (int i = tid; i < 1024; i += 512) {
            const int pos = i >> 4, fi = i & 15;
            const float freq = __expf(-(float)fi * 0.5756462732485115f);
            const float ang = (float)pos * freq;
            rt[i] = __cosf(ang); rt[1024 + i] = __sinf(ang);
        }
    }
    weight_units(p, 0, 0, 280, BIDX(), (int)gridDim.x, sm);
    conv_T(p.in[I_CAV], (bf16_t*)(ws + W_CVA), 512, 128, 128, 24, 100, sm);
    conv_T(p.in[I_CBV], (bf16_t*)(ws + W_CVB), 512, 128, 128, 20, 200, sm);
    conv_plain(p.in[I_CAK], (bf16_t*)(ws + W_CKA), (size_t)24 * 65536 / 4);
    conv_plain(p.in[I_CBK], (bf16_t*)(ws + W_CKB), (size_t)20 * 65536 / 4);
}
DEVI void phase0b(const P& p) {
    const float* mp = (const float*)(WSP(p.ws) + W_MODP2);
    float* mo = (float*)(WSP(p.ws) + W_MODS);
    for (int i = BIDX() * 512 + TIDX(); i < 2 * 3 * 12288; i += gridDim.x * 512) {
        const int l = i / 36864, r = i % 36864, ci = r / 12288, j = r % 12288;
        float s = p.in[I_BMOD][l * 12288 + j];
        float s2 = 0.f, s3 = 0.f, s4 = 0.f;
#pragma unroll 4
        for (int kc = 0; kc < 64; kc += 4) {
            s += mp[((size_t)(l * 64 + kc) * 3 + ci) * 12288 + j]; s2 += mp[((size_t)(l * 64 + kc + 1) * 3 + ci) * 12288 + j];
            s3 += mp[((size_t)(l * 64 + kc + 2) * 3 + ci) * 12288 + j]; s4 += mp[((size_t)(l * 64 + kc + 3) * 3 + ci) * 12288 + j];
        }
        s += s2 + s3 + s4;
        mo[i] = s;
    }
}
DEVI void phase0c(const P& p) {
    const float* __restrict__ mods = (const float*)(WSP(p.ws) + W_MODS);
    bf16_t* __restrict__ H = (bf16_t*)(WSP(p.ws) + W_H);
    const float* __restrict__ xp = p.in[I_XP]; const float* __restrict__ xs = p.in[I_XS];
    const int nthr = gridDim.x * 512;
    for (int i0 = BIDX() * 512 + TIDX(); i0 < T * 512; i0 += 4 * nthr) {
        f32x4 x[4], sh[4], sc[4];
#pragma unroll
        for (int u = 0; u < 4; ++u) {
            const int i = i0 + u * nthr;
            if (i < T * 512) {
                const int t = i >> 9, c = (i & 511) * 4;
                const float* xr = t < TC ? xp + (size_t)t * D : xs + (size_t)(t - TC) * D;
                const float* mr = mods + (size_t)cond_of_row(t) * 12288;
                x[u] = *(const f32x4*)(xr + c); sh[u] = *(const f32x4*)(mr + c); sc[u] = *(const f32x4*)(mr + 2048 + c);
            }
        }
#pragma unroll
        for (int u = 0; u < 4; ++u) {
            const int i = i0 + u * nthr;
            if (i < T * 512) { const int t = i >> 9, c = (i & 511) * 4; st4(H + (size_t)t * D + c, x[u] * (1.0f + sc[u]) + sh[u]); }
        }
    }
}

struct EpiIn {
    static constexpr bool PERM = false, AFTER_DRAIN = false;
    char* ws; float* out; const float* gate_b; int l;
    DEVI void operator()(const f32x4 (&acc)[2][2][4][2], const pg8::Unit& u, int wr, int wc, int fr, int fq) const {
        asm volatile("" : "+v"(fr), "+v"(fq), "+s"(wr), "+s"(wc));
        const bool ctx = u.pm < 16;
        const int b = ctx ? u.pm : ((u.pm - 16) >> 3);
        const int sbase = (ctx ? 0 : ((u.pm - 16) & 7) * 256) + wr * 64 + fr;
        const int rbase = u.pm * 256 + wr * 64 + fr;
        const int S = ctx ? 256 : 2048;
        const int dc = wc * 32 + fq * 4;
        const float* rope = (const float*)(ws + W_ROPE);
        const int lay = l;
        half<0>(acc, u, wr, wc, fr, fq, ctx, b, sbase, rbase, S, dc, rope, lay);
        half<1>(acc, u, wr, wc, fr, fq, ctx, b, sbase, rbase, S, dc, rope, lay);
    }
    template <int bj>
    DEVI void half(const f32x4 (&acc)[2][2][4][2], const pg8::Unit& u, int wr, int wc, int fr, int fq, bool ctx, int b, int sbase, int rbase, int S, int dc, const float* rope, int lay) const {
        {
            const int cgi = 2 * u.pn + bj;
            if (cgi >= 54) return;
            auto each = [&](auto f) __attribute__((always_inline)) {
#pragma unroll
                for (int ai = 0; ai < 2; ++ai)
#pragma unroll
                    for (int m = 0; m < 4; ++m)
#pragma unroll
                        for (int n = 0; n < 2; ++n) f(acc[ai][bj][m][n], rbase + 128 * ai + 16 * m, sbase + 128 * ai + 16 * m, n);
            };
            auto tokmaj = [&](bf16_t* base, int stride, int head, float mul) __attribute__((always_inline)) {
                each([&](f32x4 v, int r, int s, int n) __attribute__((always_inline)) { st4(base + (size_t)r * stride + head * 128 + dc + 16 * n, v * mul); });
            };
            auto transp = [&](bf16_t* base, int Hn, int head) __attribute__((always_inline)) {
                bf16_t* bb = base + (ctx ? (size_t)0 : (size_t)16 * Hn * 32768) + (size_t)(b * Hn + head) * 128 * S;
                each([&](f32x4 v, int r, int s, int n) __attribute__((always_inline)) {
                    const unsigned A = cvt_pk_bf16(v[0], v[1]), B = cvt_pk_bf16(v[2], v[3]);
                    const bool odd = (fr & 1) != 0;
                    const unsigned recv = (unsigned)__builtin_amdgcn_mov_dpp((int)(odd ? A : B), 0xB1, 0xF, 0xF, true);
                    const unsigned w0 = odd ? ((recv & 0xffffu) | (B << 16)) : ((A & 0xffffu) | (recv << 16));
                    const unsigned w1 = odd ? ((recv >> 16) | (B & 0xffff0000u)) : ((A >> 16) | (recv & 0xffff0000u));
                    const int dd = dc + 16 * n + (odd ? 2 : 0), s2 = odd ? s - 1 : s;
                    *(unsigned*)(bb + (size_t)dd * S + s2) = w0;
                    *(unsigned*)(bb + (size_t)(dd + 1) * S + s2) = w1;
                });
            };
            auto outf = [&](float* obase, int Hn, int head) __attribute__((always_inline)) {
                float* ob = obase + (size_t)((b * 2 + lay) * Hn + head) * 32768;
                each([&](f32x4 v, int r, int s, int n) __attribute__((always_inline)) { *(f32x4*)(ob + (size_t)s * 128 + dc + 16 * n) = v; });
            };
            if (cgi < 6) {
                tokmaj((bf16_t*)(ws + W_QA), 768, cgi, 1.0f);
            } else if (cgi < 12) {
                tokmaj((bf16_t*)(ws + W_KA), 768, cgi - 6, 1.0f);
                if (ctx) outf(out + O_AK, 6, cgi - 6);
            } else if (cgi < 18) {
                transp((bf16_t*)(ws + W_VAT), 6, cgi - 12);
                if (ctx) outf(out + O_AV, 6, cgi - 12);
            } else if (cgi < 28) {
                const bool isq = cgi < 23;
                const int head = isq ? cgi - 18 : cgi - 23;
                if (isq || ctx) tokmaj((bf16_t*)(ws + (isq ? W_QB : W_KB)), 640, head, 1.0f);
                if (!isq && ctx) outf(out + O_BK, 5, head);
                if (!ctx) {
                    bf16_t* rb = isq ? (bf16_t*)(ws + W_QBR) + (size_t)(rbase - TC) * 640 : (bf16_t*)(ws + W_KB) + (size_t)rbase * 640;
#pragma unroll
                    for (int ai = 0; ai < 2; ++ai)
#pragma unroll
                        for (int m = 0; m < 4; ++m) {
                            const int s = sbase + 128 * ai + 16 * m;
                            const int pos = (wc & 1) ? (s & 63) : (s >> 6);
                            const f32x4 cs = *(const f32x4*)(rope + pos * 16 + 4 * fq), sn = *(const f32x4*)(rope + 1024 + pos * 16 + 4 * fq);
                            const f32x4 x1 = acc[ai][bj][m][0], x2 = acc[ai][bj][m][1];
                            bf16_t* d = rb + (size_t)(128 * ai + 16 * m) * 640 + head * 128 + dc;
                            st4(d, x1 * cs - x2 * sn);
                            st4(d + 16, x1 * sn + x2 * cs);
                        }
                }
            } else if (cgi < 33) {
                transp((bf16_t*)(ws + W_VBT), 5, cgi - 28);
                if (ctx) outf(out + O_BV, 5, cgi - 28);
            } else if (cgi < 38) {
                tokmaj((bf16_t*)(ws + W_QC), 640, cgi - 33, 0.08838834764831845f);
            } else if (cgi < 43) {
                tokmaj((bf16_t*)(ws + W_KC), 640, cgi - 38, 1.0f);
                transp((bf16_t*)(ws + W_KCT), 5, cgi - 38);
            } else if (cgi < 48) {
                transp((bf16_t*)(ws + W_VCT), 5, cgi - 43);
            } else if (cgi < 53) {
                bf16_t* base = (bf16_t*)(ws + W_OG);
                const int head = cgi - 48;
                each([&](f32x4 v, int r, int s, int n) __attribute__((always_inline)) {
                    f32x4 o;
#pragma unroll
                    for (int i = 0; i < 4; ++i) o[i] = sigmoidf_(v[i]);
                    st4(base + (size_t)r * 640 + head * 128 + dc + 16 * n, o);
                });
            } else {
                if (wc == 0) {
                    float* G = (float*)(ws + W_G);
                    each([&](f32x4 v, int r, int s, int n) __attribute__((always_inline)) {
                        if (n == 0 || fq == 0) {
#pragma unroll
                            for (int i = 0; i < 4; ++i) {
                                const int col = 16 * n + 4 * fq + i;
                                float x = v[i] + gate_b[lay * 20 + col];
                                if ((col / 5) & 1) { const float ee = __expf(-fabsf(x)), uu = 1.0f + ee, dd = uu - 1.0f; x = fminf(x, 0.f) - (dd == 0.f ? ee : __logf(uu) * (ee / dd)); }
                                G[(size_t)r * 20 + col] = x;
                            }
                        }
                    });
                }
            }
        }
    }
};
struct EpiRes {
    static constexpr bool PERM = false, AFTER_DRAIN = false;
    const float* xin_c; const float* xin_l; float* X; const float* gate;
    DEVI void operator()(const f32x4 (&acc)[2][2][4][2], const pg8::Unit& u, int wr, int wc, int fr, int fq) const {
        asm volatile("" : "+v"(fr), "+v"(fq), "+s"(wr), "+s"(wc));
        const int row0 = u.pm * 256 + wr * 64 + fr, col0 = u.pn * 256 + wc * 32 + 4 * fq;
        const float* gr = gate + (size_t)(u.pm < 16 ? 0 : 1 + ((u.pm - 16) >> 3)) * 12288;
        f32x4 gv[2][2];
#pragma unroll
        for (int bj = 0; bj < 2; ++bj)
#pragma unroll
            for (int n = 0; n < 2; ++n) gv[bj][n] = *(const f32x4*)(gr + col0 + bj * 128 + n * 16);
#pragma unroll
        for (int ai = 0; ai < 2; ++ai)
#pragma unroll
            for (int m = 0; m < 4; ++m) {
                const int r = row0 + ai * 128 + m * 16;
                const float* xr = (r < TC ? xin_c + (size_t)r * D : xin_l + (size_t)(r - TC) * D) + col0;
                float* xo = X + (size_t)r * D + col0;
#pragma unroll
                for (int bj = 0; bj < 2; ++bj)
#pragma unroll
                    for (int n = 0; n < 2; ++n) {
                        const f32x4 xv = *(const f32x4*)(xr + bj * 128 + n * 16);
                        *(f32x4*)(xo + bj * 128 + n * 16) = ALPHA * xv + gv[bj][n] * acc[ai][bj][m][n];
                    }
            }
    }
};
struct EpiResLN {
    static constexpr bool PERM = true, AFTER_DRAIN = true;
    const float* xin_c; const float* xin_l; float* xout; const float* gate; const float* gam; const float* bet; const float* hmods; bf16_t* H; float* stats; unsigned* cnt; int xs_in, xs_out;
    DEVI void operator()(const f32x4 (&)[2][2][4][2], const pg8::Unit&, int, int, int, int) const {}
    DEVI void fused(f32x4 (&acc)[2][2][4][2], const pg8::Unit& u, int wr, int wc, int fr, int fq, PG8_LAS unsigned char* lds, int wid, int lane) const {
        asm volatile("" : "+v"(fr), "+v"(fq), "+s"(wr), "+s"(wc));
        const int tid = wid * 64 + lane;
        const int cond = u.pm < 16 ? 0 : 1 + ((u.pm - 16) >> 3);
        const int row0 = u.pm * 256 + wr * 64 + fr, col0 = u.pn * 256 + wc * 32 + 8 * fq;
        {
            const float* gr = gate + (size_t)cond * 12288 + col0;
            f32x4 gv[2][2];
#pragma unroll
            for (int bj = 0; bj < 2; ++bj)
#pragma unroll
                for (int n = 0; n < 2; ++n) gv[bj][n] = *(const f32x4*)(gr + bj * 128 + n * 4);
#pragma unroll
            for (int ai = 0; ai < 2; ++ai)
#pragma unroll
                for (int m = 0; m < 4; ++m) {
                    const int r = row0 + ai * 128 + m * 16;
                    const float* xr = (r < TC ? xin_c + (size_t)r * xs_in : xin_l + (size_t)(r - TC) * xs_in) + col0;
#pragma unroll
                    for (int bj = 0; bj < 2; ++bj)
#pragma unroll
                        for (int n = 0; n < 2; ++n) acc[ai][bj][m][n] = ALPHA * *(const f32x4*)(xr + bj * 128 + n * 4) + gv[bj][n] * acc[ai][bj][m][n];
                }
        }
        PG8_LAS float* red = (PG8_LAS float*)lds;
        PG8_LAS float* mr = (PG8_LAS float*)(lds + 32768);
#pragma unroll
        for (int ai = 0; ai < 2; ++ai)
#pragma unroll
            for (int m = 0; m < 4; ++m) {
                float sv = 0.f, qv = 0.f;
#pragma unroll
                for (int bj = 0; bj < 2; ++bj)
#pragma unroll
                    for (int n = 0; n < 2; ++n) {
                        const f32x4 z = acc[ai][bj][m][n];
                        sv += z[0] + z[1] + z[2] + z[3];
                        qv += z[0] * z[0] + z[1] * z[1] + z[2] * z[2] + z[3] * z[3];
                    }
                { const int rl = ai * 128 + wr * 64 + m * 16 + fr; red[(rl * 16 + wc * 4 + fq) * 2] = sv; red[(rl * 16 + wc * 4 + fq) * 2 + 1] = qv; }
            }
        __syncthreads();
        float* st = stats + ((size_t)u.pm * 256) * 16;
        if (tid < 256) {
            float sv = 0.f, qv = 0.f;
#pragma unroll
            for (int w = 0; w < 16; ++w) { sv += red[(tid * 16 + w) * 2]; qv += red[(tid * 16 + w) * 2 + 1]; }
            st[(tid * 8 + u.pn) * 2] = sv; st[(tid * 8 + u.pn) * 2 + 1] = qv;
        }
        asm volatile("s_waitcnt vmcnt(0)" ::: "memory");
        __syncthreads();
        if (tid == 0) {
            __hip_atomic_fetch_add(cnt + u.pm, 1u, __ATOMIC_RELEASE, __HIP_MEMORY_SCOPE_AGENT);
            while (__hip_atomic_load(cnt + u.pm, __ATOMIC_RELAXED, __HIP_MEMORY_SCOPE_AGENT) < 8u) {}
        }
        __syncthreads();
        if (tid < 256) {
            __builtin_amdgcn_fence(__ATOMIC_ACQUIRE, "agent");
            float sv = 0.f, qv = 0.f;
#pragma unroll
            for (int w = 0; w < 8; ++w) {
                sv += __builtin_nontemporal_load(st + (tid * 8 + w) * 2); qv += __builtin_nontemporal_load(st + (tid * 8 + w) * 2 + 1);
            }
            const float mu = sv * (1.0f / D), var = fmaxf(qv * (1.0f / D) - mu * mu, 0.f);
            mr[tid * 2] = mu; mr[tid * 2 + 1] = rsqrtf(var + 1e-5f);
        }
        __syncthreads();
        {
            float mu[8], rs_[8];
#pragma unroll
            for (int ai = 0; ai < 2; ++ai)
#pragma unroll
                for (int m = 0; m < 4; ++m) { const int rl = ai * 128 + wr * 64 + m * 16 + fr; mu[ai * 4 + m] = mr[rl * 2]; rs_[ai * 4 + m] = mr[rl * 2 + 1]; }
#pragma unroll
            for (int bj = 0; bj < 2; ++bj) {
                const int c = col0 + bj * 128;
                f32x4 gmv[2], btv[2], shv[2], scv[2];
#pragma unroll
                for (int n = 0; n < 2; ++n) {
                    gmv[n] = *(const f32x4*)(gam + c + 4 * n); btv[n] = *(const f32x4*)(bet + c + 4 * n);
                    shv[n] = (f32x4){0.f, 0.f, 0.f, 0.f}; scv[n] = shv[n];
                    if (hmods) { const float* hm = hmods + (size_t)cond * 12288 + c + 4 * n; shv[n] = *(const f32x4*)hm; scv[n] = 1.0f + *(const f32x4*)(hm + 2048); }
                }
#pragma unroll
                for (int ai = 0; ai < 2; ++ai)
#pragma unroll
                    for (int m = 0; m < 4; ++m) {
                        const int r = u.pm * 256 + ai * 128 + wr * 64 + m * 16 + fr;
                        const f32x4 y0 = (acc[ai][bj][m][0] - mu[ai * 4 + m]) * rs_[ai * 4 + m] * gmv[0] + btv[0];
                        const f32x4 y1 = (acc[ai][bj][m][1] - mu[ai * 4 + m]) * rs_[ai * 4 + m] * gmv[1] + btv[1];
                        *(f32x4*)(xout + (size_t)r * xs_out + c) = y0; *(f32x4*)(xout + (size_t)r * xs_out + c + 4) = y1;
                        if (hmods) {
                            const f32x4 h0 = y0 * scv[0] + shv[0], h1 = y1 * scv[1] + shv[1];
                            const u32x4 o = {cvt_pk_bf16(h0[0], h0[1]), cvt_pk_bf16(h0[2], h0[3]), cvt_pk_bf16(h1[0], h1[1]), cvt_pk_bf16(h1[2], h1[3])};
                            *(u32x4*)(H + (size_t)r * D + c) = o;
                        }
                    }
            }
        }
    }
};
struct EpiU {
    static constexpr bool PERM = true, AFTER_DRAIN = false;
    bf16_t* U;
    DEVI void operator()(const f32x4 (&acc)[2][2][4][2], const pg8::Unit& u, int wr, int wc, int fr, int fq) const {
        asm volatile("" : "+v"(fr), "+v"(fq), "+s"(wr), "+s"(wc));
        const int row0 = u.pm * 256 + wr * 64 + fr, col0 = u.pn * 256 + wc * 32 + 8 * fq;
#pragma unroll
        for (int ai = 0; ai < 2; ++ai)
#pragma unroll
            for (int m = 0; m < 4; ++m) {
                bf16_t* ur = U + (size_t)(row0 + ai * 128 + m * 16) * NUP + col0;
#pragma unroll
                for (int bj = 0; bj < 2; ++bj) {
                    const f32x4 v0 = acc[ai][bj][m][0], v1 = acc[ai][bj][m][1];
                    const u32x4 o = {cvt_pk_bf16(v0[0], v0[1]), cvt_pk_bf16(v0[2], v0[3]), cvt_pk_bf16(v1[0], v1[1]), cvt_pk_bf16(v1[2], v1[3])};
                    *(u32x4*)(ur + bj * 128) = o;
                }
            }
    }
};

DEVI void ln_phase(const P& p, int l, int which) {
    const int lane = TIDX() & 63, wid = TIDX() >> 6;
    float* X = (float*)(WSP(p.ws) + W_X);
    const float* gam = p.in[which ? I_LN2G : I_LN1G] + l * D;
    const float* bet = p.in[which ? I_LN2B : I_LN1B] + l * D;
    const bool last = which == 1 && l == 1;
    const float* mods = (const float*)(WSP(p.ws) + W_MODS) + (size_t)(which ? l + 1 : l) * 36864 + (which ? 0 : 3 * 2048);
    bf16_t* H = (bf16_t*)(WSP(p.ws) + W_H);
    f32x4 gv[8], bv[8];
#pragma unroll
    for (int j = 0; j < 8; ++j) { gv[j] = *(const f32x4*)(gam + 4 * lane + 256 * j); bv[j] = *(const f32x4*)(bet + 4 * lane + 256 * j); }
    const int wstride = gridDim.x * 8;
    for (int t0 = BIDX() * 8 + wid; t0 < T; t0 += 2 * wstride) {
        const int t1 = t0 + wstride;
        const bool has1 = t1 < T;
        f32x4 v0[8], v1[8];
        float s0 = 0.f, s1 = 0.f;
#pragma unroll
        for (int j = 0; j < 8; ++j) v0[j] = *(const f32x4*)(X + (size_t)t0 * D + 4 * lane + 256 * j);
#pragma unroll
        for (int j = 0; j < 8; ++j) v1[j] = has1 ? *(const f32x4*)(X + (size_t)t1 * D + 4 * lane + 256 * j) : (f32x4){0.f, 0.f, 0.f, 0.f};
#pragma unroll
        for (int j = 0; j < 8; ++j) { s0 += v0[j][0] + v0[j][1] + v0[j][2] + v0[j][3]; s1 += v1[j][0] + v1[j][1] + v1[j][2] + v1[j][3]; }
#pragma unroll
        for (int o = 32; o > 0; o >>= 1) { s0 += __shfl_xor(s0, o); s1 += __shfl_xor(s1, o); }
        const float mu0 = s0 * (1.0f / D), mu1 = s1 * (1.0f / D);
        float q0 = 0.f, q1 = 0.f;
#pragma unroll
        for (int j = 0; j < 8; ++j) {
            v0[j] -= mu0; v1[j] -= mu1;
            q0 += v0[j][0] * v0[j][0] + v0[j][1] * v0[j][1] + v0[j][2] * v0[j][2] + v0[j][3] * v0[j][3];
            q1 += v1[j][0] * v1[j][0] + v1[j][1] * v1[j][1] + v1[j][2] * v1[j][2] + v1[j][3] * v1[j][3];
        }
#pragma unroll
        for (int o = 32; o > 0; o >>= 1) { q0 += __shfl_xor(q0, o); q1 += __shfl_xor(q1, o); }
        const float r0 = rsqrtf(q0 * (1.0f / D) + 1e-5f), r1 = rsqrtf(q1 * (1.0f / D) + 1e-5f);
#pragma unroll
        for (int rr = 0; rr < 2; ++rr) {
            if (rr == 1 && !has1) break;
            const int t = rr ? t1 : t0;
            const float rstd = rr ? r1 : r0;
            float* dst = last ? p.out + O_Y + (size_t)t * D : X + (size_t)t * D;
            const float* mr = mods + (size_t)cond_of_row(t) * 12288;
#pragma unroll
            for (int j = 0; j < 8; ++j) {
                const int c = 4 * lane + 256 * j;
                const f32x4 y = (rr ? v1[j] : v0[j]) * rstd * gv[j] + bv[j];
                *(f32x4*)(dst + c) = y;
                if (!last) st4(H + (size_t)t * D + c, y * (1.0f + *(const f32x4*)(mr + 2048 + c)) + *(const f32x4*)(mr + c));
            }
        }
    }
}

DEVI void conv_phase(const P& p, int l) {
    const bf16_t* U = (const bf16_t*)(WSP(p.ws) + W_U);
    bf16_t* A = (bf16_t*)(WSP(p.ws) + W_ACT);
    const float* cw = p.in[I_CONVW] + (size_t)l * 3 * NUP;
    const float* cb = p.in[I_CONVB] + (size_t)l * NUP;
    for (int id = BIDX() * 512 + TIDX(); id < 512 * 688; id += gridDim.x * 512) {
        const int trun = id / 688, cgp = id % 688, j0 = cgp * 8, t0 = trun * 16;
        const int S = t0 < TC ? 256 : 2048;
        const int s0 = t0 < TC ? (t0 & 255) : ((t0 - TC) & 2047);
        float wa[3][8], wg[3][8], ba[8], bg[8];
#pragma unroll
        for (int k = 0; k < 3; ++k)
#pragma unroll
            for (int h = 0; h < 2; ++h) {
                const f32x4 x = *(const f32x4*)(cw + (size_t)k * NUP + j0 + 4 * h), y = *(const f32x4*)(cw + (size_t)k * NUP + DFF + j0 + 4 * h);
#pragma unroll
                for (int i = 0; i < 4; ++i) { wa[k][4 * h + i] = x[i]; wg[k][4 * h + i] = y[i]; }
            }
#pragma unroll
        for (int h = 0; h < 2; ++h) {
            const f32x4 x = *(const f32x4*)(cb + j0 + 4 * h), y = *(const f32x4*)(cb + DFF + j0 + 4 * h);
#pragma unroll
            for (int i = 0; i < 4; ++i) { ba[4 * h + i] = x[i]; bg[4 * h + i] = y[i]; }
        }
        const u32x4 zero = {0u, 0u, 0u, 0u};
        auto lda = [&](int t) { return *(const u32x4*)(U + (size_t)t * NUP + j0); };
        auto ldg = [&](int t) { return *(const u32x4*)(U + (size_t)t * NUP + DFF + j0); };
        u32x4 pa = s0 > 0 ? lda(t0 - 1) : zero, pg = s0 > 0 ? ldg(t0 - 1) : zero;
        u32x4 ca = lda(t0), cgv = ldg(t0);
        auto outrow = [&](int t, const u32x4& xa, const u32x4& ya, const u32x4& za, const u32x4& xg, const u32x4& yg, const u32x4& zg) {
            float o[8];
#pragma unroll
            for (int w = 0; w < 4; ++w) {
                const float a0 = wa[0][2 * w] * bflo(xa[w]) + wa[1][2 * w] * bflo(ya[w]) + wa[2][2 * w] * bflo(za[w]) + ba[2 * w];
                const float a1 = wa[0][2 * w + 1] * bfhi(xa[w]) + wa[1][2 * w + 1] * bfhi(ya[w]) + wa[2][2 * w + 1] * bfhi(za[w]) + ba[2 * w + 1];
                const float g0 = wg[0][2 * w] * bflo(xg[w]) + wg[1][2 * w] * bflo(yg[w]) + wg[2][2 * w] * bflo(zg[w]) + bg[2 * w];
                const float g1 = wg[0][2 * w + 1] * bfhi(xg[w]) + wg[1][2 * w + 1] * bfhi(yg[w]) + wg[2][2 * w + 1] * bfhi(zg[w]) + bg[2 * w + 1];
                o[2 * w] = siluf_(g0) * a0; o[2 * w + 1] = siluf_(g1) * a1;
            }
            const u32x4 ov = {cvt_pk_bf16(o[0], o[1]), cvt_pk_bf16(o[2], o[3]), cvt_pk_bf16(o[4], o[5]), cvt_pk_bf16(o[6], o[7])};
            *(u32x4*)(A + (size_t)t * DFF + j0) = ov;
        };
        for (int i = 0; i < 16; i += 4) {
            const int t = t0 + i;
            u32x4 na[4], ng[4];
#pragma unroll
            for (int k = 0; k < 4; ++k) {
                const bool hn = (s0 + i + k + 1) < S;
                na[k] = hn ? lda(t + k + 1) : zero; ng[k] = hn ? ldg(t + k + 1) : zero;
            }
            outrow(t, pa, ca, na[0], pg, cgv, ng[0]);
            outrow(t + 1, ca, na[0], na[1], cgv, ng[0], ng[1]);
            outrow(t + 2, na[0], na[1], na[2], ng[0], ng[1], ng[2]);
            outrow(t + 3, na[1], na[2], na[3], ng[1], ng[2], ng[3]);
            pa = na[2]; pg = ng[2]; ca = na[3]; cgv = ng[3];
        }
    }
}

constexpr size_t LATV_A = (size_t)16 * 6 * 32768, LATV_B = (size_t)16 * 5 * 32768;
template <bool DIFF>
DEVI void attn_item(const bf16_t* qrow0, const bf16_t* qrow1,
                    const bf16_t* K0, int ks0, int kstart0, int tstep0, int nt0, const bf16_t* VT0, int vs0,
                    const bf16_t* K1, int ks1, int nt1, const bf16_t* VT1, int vs1,
                    bool neigh, int qr, int qc0, int c0, int rs, const float* rpb_h,
                    float sc2, bf16_t* yrow, float lam, const float* subln, float outscale) {
    constexpr int NMAP = DIFF ? 2 : 1, NKK = DIFF ? 2 : 4;
    const int lane = TIDX() & 63, l16 = lane & 15, g = lane >> 4;
    float mrun[NMAP], lrun[NMAP];
    f32x4 o[NMAP][8];
#pragma unroll
    for (int mp = 0; mp < NMAP; ++mp) {
        mrun[mp] = -1e30f; lrun[mp] = 0.f;
#pragma unroll
        for (int dt = 0; dt < 8; ++dt) o[mp][dt] = (f32x4){0.f, 0.f, 0.f, 0.f};
    }
    bf16x8 qf[NMAP][NKK];
#pragma unroll
    for (int mp = 0; mp < NMAP; ++mp)
#pragma unroll
        for (int kk = 0; kk < NKK; ++kk) qf[mp][kk] = ld8(qrow0 + (mp * NKK + kk) * 32 + 8 * g);
    const int qc = qc0 + l16, cs = clampi(qc - 8, 0, 48);
    const int ntot = nt0 + nt1;
    for (int j = 0; j < ntot; ++j) {
        const bool s0 = j < nt0;
        if (j == nt0 && qrow1 != qrow0) {
#pragma unroll
            for (int mp = 0; mp < NMAP; ++mp)
#pragma unroll
                for (int kk = 0; kk < NKK; ++kk) qf[mp][kk] = ld8(qrow1 + (mp * NKK + kk) * 32 + 8 * g);
        }
        const int key0 = s0 ? kstart0 + j * tstep0 : (j - nt0) * 32;
        const int ks = s0 ? ks0 : ks1, vs = s0 ? vs0 : vs1;
        const bf16_t* Kt = (s0 ? K0 : K1) + (size_t)key0 * ks + (size_t)l16 * ks + 8 * g;
        const bf16_t* Vt = (s0 ? VT0 : VT1) + key0 + (size_t)l16 * vs + 4 * g;
        f32x4 s[NMAP][2];
#pragma unroll
        for (int mp = 0; mp < NMAP; ++mp)
#pragma unroll
            for (int half = 0; half < 2; ++half) {
                f32x4 a = {0.f, 0.f, 0.f, 0.f};
#pragma unroll
                for (int kk = 0; kk < NKK; ++kk) a = mfma16(ld8(Kt + (size_t)(16 * half) * ks + (mp * NKK + kk) * 32), qf[mp][kk], a);
                s[mp][half] = a;
            }
        bf16x8 vf[8];
#pragma unroll
        for (int dt = 0; dt < 8; ++dt) vf[dt] = ld4x2(Vt + (size_t)(16 * dt) * vs, Vt + (size_t)(16 * dt) * vs + 16);
#pragma unroll
        for (int mp = 0; mp < NMAP; ++mp) {
            float v[8];
#pragma unroll
            for (int half = 0; half < 2; ++half)
#pragma unroll
                for (int i = 0; i < 4; ++i) v[half * 4 + i] = s[mp][half][i] * sc2;
            if (neigh && s0) {
                const float* brow = rpb_h + (7 + rs + j - qr) * 31;
#pragma unroll
                for (int half = 0; half < 2; ++half)
#pragma unroll
                    for (int i = 0; i < 4; ++i) {
                        const int kc = c0 + 16 * half + 4 * g + i;
                        const bool ok = kc >= cs && kc < cs + 16;
                        const float bv = brow[clampi(kc - qc + 15, 0, 30)] * LOG2E;
                        v[half * 4 + i] = ok ? v[half * 4 + i] + bv : -1e30f;
                    }
            }
            float tm = fmaxf(fmaxf(fmaxf(v[0], v[1]), fmaxf(v[2], v[3])), fmaxf(fmaxf(v[4], v[5]), fmaxf(v[6], v[7])));
            tm = fmaxf(tm, __shfl_xor(tm, 16)); tm = fmaxf(tm, __shfl_xor(tm, 32));
            const float mnew = fmaxf(mrun[mp], tm), alpha = ex2(mrun[mp] - mnew);
            mrun[mp] = mnew;
            f32x4 p0, p1; float ps = 0.f;
#pragma unroll
            for (int i = 0; i < 4; ++i) { p0[i] = ex2(v[i] - mnew); p1[i] = ex2(v[4 + i] - mnew); ps += p0[i] + p1[i]; }
            lrun[mp] = lrun[mp] * alpha + ps;
            const bf16x8 pb = pack8(p0, p1);
#pragma unroll
            for (int dt = 0; dt < 8; ++dt) o[mp][dt] = mfma16(vf[dt], pb, o[mp][dt] * alpha);
        }
    }
    float inv[NMAP];
#pragma unroll
    for (int mp = 0; mp < NMAP; ++mp) { float lsum = lrun[mp]; lsum += __shfl_xor(lsum, 16); lsum += __shfl_xor(lsum, 32); inv[mp] = 1.0f / lsum; }
    if constexpr (!DIFF) {
#pragma unroll
        for (int dt = 0; dt < 8; ++dt) st4(yrow + 16 * dt + 4 * g, o[0][dt] * inv[0]);
    } else {
        float ss = 0.f;
        f32x4 ov[8];
#pragma unroll
        for (int dt = 0; dt < 8; ++dt) {
            ov[dt] = o[0][dt] * inv[0] - (lam * inv[1]) * o[1][dt];
            ss += ov[dt][0] * ov[dt][0] + ov[dt][1] * ov[dt][1] + ov[dt][2] * ov[dt][2] + ov[dt][3] * ov[dt][3];
        }
        ss += __shfl_xor(ss, 16); ss += __shfl_xor(ss, 32);
        const float rinv = rsqrtf(ss * (1.0f / 128.0f) + 1e-6f) * outscale;
#pragma unroll
        for (int dt = 0; dt < 8; ++dt) st4(yrow + 16 * dt + 4 * g, ov[dt] * rinv * *(const f32x4*)(subln + 16 * dt + 4 * g));
    }
}

DEVI float incl_scan_sum(float v, int lane) {
#pragma unroll
    for (int o = 1; o < 64; o <<= 1) { const float t = __shfl_up(v, o); if (lane >= o) v += t; }
    return v;
}
DEVI float incl_scan_max(float v, int lane) {
#pragma unroll
    for (int o = 1; o < 64; o <<= 1) { const float t = __shfl_up(v, o); if (lane >= o) v = fmaxf(v, t); }
    return v;
}
DEVI bf16x8 ones_row(int l16) { const short v = (short)(l16 == 0 ? 0x3F80 : 0); return (bf16x8){v, v, v, v, v, v, v, v}; }
DEVI bf16x8 ldf8(const float* p) { return pack8(*(const f32x4*)p, *(const f32x4*)(p + 4)); }

DEVI void m1_item(const P& p, int slot) {
    const int lane = TIDX() & 63, l16 = lane & 15, g = lane >> 4;
    int chunk, dir, bh, tok0, vs; size_t tb;
    if (slot < 640) { chunk = slot & 3; dir = (slot >> 2) & 1; bh = slot >> 3; tok0 = (bh / 5) * 256 + chunk * 64; vs = 256; tb = (size_t)bh * 128 * 256 + chunk * 64; }
    else { const int q = slot - 640; chunk = q & 31; dir = (q >> 5) & 1; bh = q >> 6; tok0 = TC + (bh / 5) * 2048 + chunk * 64; vs = 2048; tb = LATV_B + (size_t)bh * 128 * 2048 + chunk * 64; }
    const int h = bh % 5;
    char* ws = WSP(p.ws);
    const float* G = (const float*)(ws + W_G) + (size_t)(tok0 + lane) * 20;
    const float f = G[(dir ? 15 : 5) + h], ig = G[(dir ? 10 : 0) + h];
    const bf16_t* vct = (const bf16_t*)(ws + W_VCT) + tb + (size_t)l16 * vs + 8 * g;
    bf16x8 vf[8][2];
#pragma unroll
    for (int et = 0; et < 8; ++et)
#pragma unroll
        for (int ks = 0; ks < 2; ++ks) vf[et][ks] = ld8(vct + (size_t)(16 * et) * vs + 32 * ks);
    const float ps = incl_scan_sum(f, lane), total = __shfl(ps, 63);
    const float gs = (dir ? ps - f : total - ps) + ig;
    const float mloc = wave_max(gs), w = __expf(gs - mloc);
    float wv[2][8];
#pragma unroll
    for (int ks = 0; ks < 2; ++ks)
#pragma unroll
        for (int j = 0; j < 8; ++j) wv[ks][j] = __shfl(w, 32 * ks + 8 * g + j);
    const bf16x8 on = ones_row(l16);
    const bf16_t* kct0 = (const bf16_t*)(ws + W_KCT) + tb + (size_t)l16 * vs + 8 * g;
    float* ST0 = (float*)(ws + W_ST) + (size_t)slot * 16384 + l16;
    float* SN0 = (float*)(ws + W_SN) + (size_t)slot * 128 + l16;
#pragma unroll 1
    for (int dt = 0; dt < 8; ++dt) {
        const bf16_t* kct = kct0 + (size_t)(16 * dt) * vs;
        bf16x8 bk[2];
#pragma unroll
        for (int ks = 0; ks < 2; ++ks) {
            const u32x4 raw = *(const u32x4*)(kct + 32 * ks);
            const u32x4 r = {cvt_pk_bf16(bflo(raw[0]) * wv[ks][0], bfhi(raw[0]) * wv[ks][1]), cvt_pk_bf16(bflo(raw[1]) * wv[ks][2], bfhi(raw[1]) * wv[ks][3]),
                             cvt_pk_bf16(bflo(raw[2]) * wv[ks][4], bfhi(raw[2]) * wv[ks][5]), cvt_pk_bf16(bflo(raw[3]) * wv[ks][6], bfhi(raw[3]) * wv[ks][7])};
            bk[ks] = __builtin_bit_cast(bf16x8, r);
        }
        float* ST = ST0 + 16 * dt;
#pragma unroll
        for (int et = 0; et < 8; ++et) {
            f32x4 a = {0.f, 0.f, 0.f, 0.f};
#pragma unroll
            for (int ks = 0; ks < 2; ++ks) a = mfma16(vf[et][ks], bk[ks], a);
#pragma unroll
            for (int i = 0; i < 4; ++i) ST[(16 * et + 4 * g + i) * 128] = a[i];
        }
        f32x4 a = {0.f, 0.f, 0.f, 0.f};
#pragma unroll
        for (int ks = 0; ks < 2; ++ks) a = mfma16(on, bk[ks], a);
        if (g == 0) SN0[16 * dt] = a[0];
    }
    if (lane == 0) { float* SS = (float*)(ws + W_SS); SS[slot] = total; SS[1920 + slot] = mloc; }
}

template <int NC>
DEVI void m2_chain(float* base, size_t sstride, bf16_t* sb, float* SS, int slot0, int dir, bool act, bool wr_m, f32x4& C, float& m) {
    f32x4 kv[NC]; float bl[NC], ml[NC];
#pragma unroll
    for (int u = 0; u < NC; ++u) {
        const int slot = slot0 + (dir ? NC - 1 - u : u);
        kv[u] = act ? *(const f32x4*)(base + (size_t)slot * sstride) : (f32x4){0.f, 0.f, 0.f, 0.f};
        bl[u] = SS[slot]; ml[u] = SS[1920 + slot];
    }
#pragma unroll
    for (int u = 0; u < NC; ++u) {
        const int slot = slot0 + (dir ? NC - 1 - u : u);
        const float mnew = fmaxf(bl[u] + m, ml[u]), wold = __expf(bl[u] + m - mnew), wnew = __expf(ml[u] - mnew);
        if (act) { if (sb) st4(sb + (size_t)slot * 16384, C); else *(f32x4*)(base + (size_t)slot * sstride) = C; }
        if (wr_m) SS[2 * 1920 + slot] = m;
        C = wold * C + wnew * kv[u];
        m = mnew;
    }
}
DEVI void m2_phase(const P& p, int l) {
    const int tid = TIDX();
    char* ws = WSP(p.ws);
    float* SS = (float*)(ws + W_SS);
    for (int it = BIDX(); it < 180 * 9; it += gridDim.x) {
        const int sd = it / 9, slice = it % 9;
        const bool lat = sd < 20;
        const int q = lat ? sd : sd - 20, dir = q & 1, bh = q >> 1, b = bh / 5, h = bh % 5;
        const int slot0 = lat ? 640 + (bh * 2 + dir) * 32 : (bh * 2 + dir) * 4;
        const size_t sidx = (size_t)((b * 2 + l) * 2 + dir) * 5 + h;
        float m = lat ? p.in[I_SM][sidx] : 0.f;
        const bool act = slice < 8 || tid < 32;
        const int eo = slice < 8 ? slice * 2048 + tid * 4 : 0;
        const int e = eo >> 7, d0 = slice < 8 ? (eo & 127) : tid * 4;
        f32x4 C = {0.f, 0.f, 0.f, 0.f};
        if (lat && act) {
            if (slice < 8) { const float* ci = p.in[I_SC] + sidx * 16384;
#pragma unroll
                for (int i = 0; i < 4; ++i) C[i] = ci[(d0 + i) * 128 + e]; }
            else C = *(const f32x4*)(p.in[I_SN] + sidx * 128 + d0);
        }
        float* base = slice < 8 ? (float*)(ws + W_ST) + eo : (float*)(ws + W_SN) + d0;
        const size_t sstride = slice < 8 ? 16384 : 128;
        const bool wr_m = slice == 0 && tid == 0;
        bf16_t* sb = slice < 8 ? (bf16_t*)(ws + W_ACT) + eo : nullptr;
        if (lat) m2_chain<32>(base, sstride, sb, SS, slot0, dir, act, wr_m, C, m);
        else m2_chain<4>(base, sstride, sb, SS, slot0, dir, act, wr_m, C, m);
        if (!lat && act) {
            if (slice < 8) { float* co = p.out + O_CC + sidx * 16384;
#pragma unroll
                for (int i = 0; i < 4; ++i) co[(d0 + i) * 128 + e] = C[i]; }
            else *(f32x4*)(p.out + O_CN + sidx * 128 + d0) = C;
            if (slice == 0 && tid == 0) p.out[O_CM + sidx] = m;
        }
    }
}

DEVI void m3_item(const P& p, int l, int idx) {
    const int lane = TIDX() & 63, l16 = lane & 15, g = lane >> 4;
    const int tt = idx & 3, cidx = idx >> 2;
    int bh, chunk, tok0, vs, slotf, slotb; size_t tb;
    if (cidx < 320) { bh = cidx >> 2; chunk = cidx & 3; tok0 = (bh / 5) * 256 + chunk * 64; vs = 256; tb = (size_t)bh * 128 * 256 + chunk * 64; slotf = (bh * 2) * 4 + chunk; slotb = (bh * 2 + 1) * 4 + chunk; }
    else { const int q = cidx - 320; bh = q >> 5; chunk = q & 31; tok0 = TC + (bh / 5) * 2048 + chunk * 64; vs = 2048; tb = LATV_B + (size_t)bh * 128 * 2048 + chunk * 64; slotf = 640 + (bh * 2) * 32 + chunk; slotb = 640 + (bh * 2 + 1) * 32 + chunk; }
    const int h = bh % 5, tq = 16 * tt + l16;
    const bf16_t* qrow = (const bf16_t*)(WSP(p.ws) + W_QC) + (size_t)(tok0 + tq) * 640 + h * 128 + 8 * g;
    bf16x8 qf[4];
#pragma unroll
    for (int kk = 0; kk < 4; ++kk) qf[kk] = ld8(qrow + 32 * kk);
    f32x4 sT[4];
    {
        const bf16_t* kb = (const bf16_t*)(WSP(p.ws) + W_KC) + (size_t)(tok0 + l16) * 640 + h * 128 + 8 * g;
#pragma unroll
        for (int st = 0; st < 4; ++st) {
            f32x4 a = {0.f, 0.f, 0.f, 0.f};
#pragma unroll
            for (int kk = 0; kk < 4; ++kk) a = mfma16(ld8(kb + (size_t)(16 * st) * 640 + 32 * kk), qf[kk], a);
            sT[st] = a;
        }
    }
    f32x4 hsum[8];
#pragma unroll
    for (int et = 0; et < 8; ++et) hsum[et] = (f32x4){0.f, 0.f, 0.f, 0.f};
    const float* Gp = (const float*)(WSP(p.ws) + W_G) + (size_t)(tok0 + lane) * 20;
    const float* SS = (const float*)(WSP(p.ws) + W_SS);
    const bf16_t* vtb = (const bf16_t*)(WSP(p.ws) + W_VCT) + tb + (size_t)l16 * vs + 4 * g;
    for (int dir = 0; dir < 2; ++dir) {
        const int slot = dir ? slotb : slotf;
        float f = Gp[(dir ? 15 : 5) + h], ig = Gp[(dir ? 10 : 0) + h];
        if (dir) { f = __shfl(f, 63 - lane); ig = __shfl(ig, 63 - lane); }
        const float bs = incl_scan_sum(f, lane);
        float a_ = ig - bs;
        const float pm = incl_scan_max(a_, lane);
        const float mst = SS[2 * 1920 + slot];
        const float mrow = bs + fmaxf(pm, mst);
        float c_ = bs - mrow, wst = __expf(bs + mst - mrow), emr = __expf(-mrow);
        if (dir) { a_ = __shfl(a_, 63 - lane); c_ = __shfl(c_, 63 - lane); wst = __shfl(wst, 63 - lane); emr = __shfl(emr, 63 - lane); }
        const float cq = __shfl(c_, tq), wq = __shfl(wst, tq), eq = __shfl(emr, tq);
        f32x4 o[9];
        const bf16_t* Cs = (const bf16_t*)(WSP(p.ws) + W_ACT) + (size_t)slot * 16384 + (size_t)l16 * 128 + 8 * g;
#pragma unroll
        for (int et = 0; et < 8; ++et) {
            f32x4 a = {0.f, 0.f, 0.f, 0.f};
#pragma unroll
            for (int kk = 0; kk < 4; ++kk) a = mfma16(ld8(Cs + (size_t)(16 * et) * 128 + 32 * kk), qf[kk], a);
            o[et] = a * wq;
        }
        {
            const float* ns = (const float*)(WSP(p.ws) + W_SN) + (size_t)slot * 128 + 8 * g;
            f32x4 a = {0.f, 0.f, 0.f, 0.f};
#pragma unroll
            for (int kk = 0; kk < 4; ++kk) {
                bf16x8 nf = ldf8(ns + 32 * kk);
                if (l16 != 0) nf = (bf16x8){0, 0, 0, 0, 0, 0, 0, 0};
                a = mfma16(nf, qf[kk], a);
            }
            o[8] = a * wq;
        }
        const bf16x8 on = ones_row(l16);
#pragma unroll
        for (int ks = 0; ks < 2; ++ks) {
            f32x4 pp[2];
#pragma unroll
            for (int half = 0; half < 2; ++half) {
                const int st = 2 * ks + half;
#pragma unroll
                for (int i = 0; i < 4; ++i) {
                    const int s = 16 * st + 4 * g + i;
                    const float as = __shfl(a_, s);
                    const bool ok = dir ? (s >= tq) : (s <= tq);
                    pp[half][i] = ok ? sT[st][i] * __expf(as + cq) : 0.f;
                }
            }
            const bf16x8 pb = pack8(pp[0], pp[1]);
#pragma unroll
            for (int et = 0; et < 8; ++et) o[et] = mfma16(ld4x2(vtb + (size_t)(16 * et) * vs + 32 * ks, vtb + (size_t)(16 * et) * vs + 32 * ks + 16), pb, o[et]);
            o[8] = mfma16(on, pb, o[8]);
        }
        const float den = __shfl(o[8][0], l16);
        const float dinv = 1.0f / fmaxf(fabsf(den), eq);
#pragma unroll
        for (int et = 0; et < 8; ++et) hsum[et] += o[et] * dinv;
    }
    float ss = 0.f;
#pragma unroll
    for (int et = 0; et < 8; ++et) ss += hsum[et][0] * hsum[et][0] + hsum[et][1] * hsum[et][1] + hsum[et][2] * hsum[et][2] + hsum[et][3] * hsum[et][3];
    ss += __shfl_xor(ss, 16); ss += __shfl_xor(ss, 32);
    const float rinv = rsqrtf(ss * (1.0f / 128.0f) + 1e-6f);
    const bf16_t* og = (const bf16_t*)(WSP(p.ws) + W_OG) + (size_t)(tok0 + tq) * 640 + h * 128 + 4 * g;
    const float* cn = p.in[I_CNORM] + l * 128 + 4 * g;
    bf16_t* y = (bf16_t*)(WSP(p.ws) + W_Y) + (size_t)(tok0 + tq) * D + 1408 + h * 128 + 4 * g;
#pragma unroll
    for (int et = 0; et < 8; ++et) {
        const u32x2 ou = *(const u32x2*)(og + 16 * et);
        const f32x4 ogf = {bflo(ou[0]), bfhi(ou[0]), bflo(ou[1]), bfhi(ou[1])};
        st4(y + 16 * et, hsum[et] * rinv * *(const f32x4*)(cn + 16 * et) * ogf);
    }
}

#ifndef ABUF
#define ABUF 0
#endif
constexpr int KROW = 136, VROW = 72;
constexpr int KT_EL = 64 * KROW, VT_EL = 128 * VROW;
constexpr int ATT_LDS_BYTES = (2 * KT_EL + 2 * VT_EL) * 2;
typedef PG8_LAS const bf16x8* lds_b8p;
typedef PG8_LAS const u32x2* lds_u2p;
template <int N> struct IC { static constexpr int value = N; };
template <bool DIFF, bool NEIGH>
DEVI void attn_block(PG8_LAS unsigned char* lds, const bf16_t* qrow0, const bf16_t* qrow1,
                     const bf16_t* K0, int ks0, int kstart0, int nt0, const bf16_t* VT0, int vs0,
                     const bf16_t* K1, int ks1, int nt1, const bf16_t* VT1, int vs1,
                     int qr, int qc0, int c0, int rs, int rsmin, const float* rpb_h,
                     float sc2, bf16_t* yrow, float lam, const float* subln, float outscale) {
    constexpr int NMAP = DIFF ? 2 : 1, NKK = DIFF ? 2 : 4;
    const int tid = TIDX(), lane = tid & 63, l16 = lane & 15, g = lane >> 4;
    float mrun[NMAP], lrun[NMAP];
    f32x4 o[NMAP][8];
#pragma unroll
    for (int mp = 0; mp < NMAP; ++mp) {
        mrun[mp] = -1e30f; lrun[mp] = 0.f;
#pragma unroll
        for (int dt = 0; dt < 8; ++dt) o[mp][dt] = (f32x4){0.f, 0.f, 0.f, 0.f};
    }
    bf16x8 qf[NMAP][NKK];
#pragma unroll
    for (int mp = 0; mp < NMAP; ++mp)
#pragma unroll
        for (int kk = 0; kk < NKK; ++kk) qf[mp][kk] = ld8(qrow0 + (mp * NKK + kk) * 32 + 8 * g);
    const int qc = qc0 + l16, cs = clampi(qc - 8, 0, 48);
    const int ntot = nt0 + nt1;
    u32x4 kreg[2], vreg[2];
    auto gload = [&](int t) {
        const bool s0 = t < nt0;
        const int key0 = s0 ? kstart0 + 64 * t : 64 * (t - nt0);
        const bf16_t* Kb = s0 ? K0 : K1; const bf16_t* Vb = s0 ? VT0 : VT1;
        const int ks = s0 ? ks0 : ks1, vs = s0 ? vs0 : vs1;
#pragma unroll
        for (int i = 0; i < 2; ++i) {
            const int c = tid + 512 * i;
            kreg[i] = *(const __attribute__((address_space(1))) u32x4*)(Kb + (size_t)(key0 + (c >> 4)) * ks + (c & 15) * 8);
            vreg[i] = *(const __attribute__((address_space(1))) u32x4*)(Vb + (size_t)(c >> 3) * vs + key0 + (c & 7) * 8);
        }
    };
    auto lstore = [&]() {
#pragma unroll
        for (int i = 0; i < 2; ++i) {
            const int c = tid + 512 * i;
            *(PG8_LAS u32x4*)(lds + ((c >> 4) * KROW + (c & 15) * 8) * 2) = kreg[i];
            *(PG8_LAS u32x4*)(lds + (2 * KT_EL + (c >> 3) * VROW + (c & 7) * 8) * 2) = vreg[i];
        }
    };
    PG8_LAS unsigned char* Kt = lds;
    PG8_LAS unsigned char* Vt = lds + (2 * KT_EL) * 2;
    auto step = [&](auto nsc, int kofs, bool win, int kr) {
        constexpr int NS = decltype(nsc)::value;
        f32x4 s[NMAP][NS][2];
#pragma unroll
        for (int sub = 0; sub < NS; ++sub)
#pragma unroll
            for (int mp = 0; mp < NMAP; ++mp)
#pragma unroll
                for (int half = 0; half < 2; ++half) {
                    f32x4 a = {0.f, 0.f, 0.f, 0.f};
#pragma unroll
                    for (int kk = 0; kk < NKK; ++kk) a = mfma16(*(lds_b8p)(Kt + ((kofs + 32 * sub + 16 * half + l16) * KROW + (mp * NKK + kk) * 32 + 8 * g) * 2), qf[mp][kk], a);
                    s[mp][sub][half] = a;
                }
        bf16x8 pb[NMAP][NS]; float alpha[NMAP];
#pragma unroll
        for (int mp = 0; mp < NMAP; ++mp) {
            float v[NS * 8];
#pragma unroll
            for (int sub = 0; sub < NS; ++sub)
#pragma unroll
                for (int half = 0; half < 2; ++half)
#pragma unroll
                    for (int i = 0; i < 4; ++i) v[sub * 8 + half * 4 + i] = s[mp][sub][half][i] * sc2;
            if (NEIGH && win) {
                const float* brow = rpb_h + (7 + kr - qr) * 31;
#pragma unroll
                for (int half = 0; half < 2; ++half)
#pragma unroll
                    for (int i = 0; i < 4; ++i) {
                        const int kc = c0 + 16 * half + 4 * g + i;
                        const bool ok = kc >= cs && kc < cs + 16;
                        const float bv = brow[clampi(kc - qc + 15, 0, 30)] * LOG2E;
                        v[half * 4 + i] = ok ? v[half * 4 + i] + bv : -1e30f;
                    }
            }
            float tm = v[0];
#pragma unroll
            for (int i = 1; i < NS * 8; ++i) tm = fmaxf(tm, v[i]);
            tm = fmaxf(tm, __shfl_xor(tm, 16)); tm = fmaxf(tm, __shfl_xor(tm, 32));
            const float mnew = fmaxf(mrun[mp], tm);
            alpha[mp] = ex2(mrun[mp] - mnew);
            mrun[mp] = mnew;
            float ps = 0.f;
#pragma unroll
            for (int sub = 0; sub < NS; ++sub) {
                f32x4 p0, p1;
#pragma unroll
                for (int i = 0; i < 4; ++i) { p0[i] = ex2(v[sub * 8 + i] - mnew); p1[i] = ex2(v[sub * 8 + 4 + i] - mnew); ps += p0[i] + p1[i]; }
                pb[mp][sub] = pack8(p0, p1);
            }
            lrun[mp] = lrun[mp] * alpha[mp] + ps;
        }
#pragma unroll
        for (int dt = 0; dt < 8; ++dt) {
            f32x4 acc[NMAP];
#pragma unroll
            for (int mp = 0; mp < NMAP; ++mp) acc[mp] = o[mp][dt] * alpha[mp];
#pragma unroll
            for (int sub = 0; sub < NS; ++sub) {
                const u32x2 a = *(lds_u2p)(Vt + ((16 * dt + l16) * VROW + kofs + 32 * sub + 4 * g) * 2), b = *(lds_u2p)(Vt + ((16 * dt + l16) * VROW + kofs + 32 * sub + 16 + 4 * g) * 2);
                const u32x4 r = {a[0], a[1], b[0], b[1]};
                const bf16x8 vf = __builtin_bit_cast(bf16x8, r);
#pragma unroll
                for (int mp = 0; mp < NMAP; ++mp) acc[mp] = mfma16(vf, pb[mp][sub], acc[mp]);
            }
#pragma unroll
            for (int mp = 0; mp < NMAP; ++mp) o[mp][dt] = acc[mp];
        }
    };
    gload(0); lstore(); __syncthreads();
    for (int t = 0; t < ntot; ++t) {
        if (t == nt0 && qrow1 != qrow0) {
#pragma unroll
            for (int mp = 0; mp < NMAP; ++mp)
#pragma unroll
                for (int kk = 0; kk < NKK; ++kk) qf[mp][kk] = ld8(qrow1 + (mp * NKK + kk) * 32 + 8 * g);
        }
        if (t + 1 < ntot) gload(t + 1);
        if (NEIGH && t < nt0) {
            const int kr = rsmin + t;
            if (kr >= rs && kr < rs + 8) step(IC<1>{}, c0, true, kr);
        } else {
            step(IC<2>{}, 0, false, 0);
        }
        __syncthreads();
        if (t + 1 < ntot) lstore();
        __syncthreads();
    }
    float inv[NMAP];
#pragma unroll
    for (int mp = 0; mp < NMAP; ++mp) { float lsum = lrun[mp]; lsum += __shfl_xor(lsum, 16); lsum += __shfl_xor(lsum, 32); inv[mp] = 1.0f / lsum; }
    if constexpr (!DIFF) {
#pragma unroll
        for (int dt = 0; dt < 8; ++dt) st4(yrow + 16 * dt + 4 * g, o[0][dt] * inv[0]);
    } else {
        float ss = 0.f;
        f32x4 ov[8];
#pragma unroll
        for (int dt = 0; dt < 8; ++dt) {
            ov[dt] = o[0][dt] * inv[0] - (lam * inv[1]) * o[1][dt];
            ss += ov[dt][0] * ov[dt][0] + ov[dt][1] * ov[dt][1] + ov[dt][2] * ov[dt][2] + ov[dt][3] * ov[dt][3];
        }
        ss += __shfl_xor(ss, 16); ss += __shfl_xor(ss, 32);
        const float rinv = rsqrtf(ss * (1.0f / 128.0f) + 1e-6f) * outscale;
#pragma unroll
        for (int dt = 0; dt < 8; ++dt) st4(yrow + 16 * dt + 4 * g, ov[dt] * rinv * *(const f32x4*)(subln + 16 * dt + 4 * g));
    }
}

constexpr int N_BL = 160, N_AL = 192, N_M3 = 320, N_AC = 192, N_BC = 160, N_MIX = N_BL + N_AL + N_M3 + N_AC + N_BC;
DEVI void mixer_phase(const P& p, int l, PG8_LAS unsigned char* lds) {
    const int tid = TIDX(), lane = tid & 63;
    char* ws = WSP(p.ws);
    unsigned* cnt = (unsigned*)(ws + W_CNT) + 64 * l;
    const float lam_init = l == 0 ? 0.2f : 0.35550906759f;
    float lam;
    {
        const float* bl = p.in[I_LAMBDA] + l * 256;
        const float s1 = wave_sum(bl[lane] * bl[64 + lane]), s2 = wave_sum(bl[128 + lane] * bl[192 + lane]);
        lam = __expf(s1) - __expf(s2) + lam_init;
        lam = __int_as_float(__builtin_amdgcn_readfirstlane(__float_as_int(lam)));
    }
    const bf16_t* Qa = (const bf16_t*)(ws + W_QA); const bf16_t* Ka = (const bf16_t*)(ws + W_KA); const bf16_t* VaT = (const bf16_t*)(ws + W_VAT);
    const bf16_t* Qb = (const bf16_t*)(ws + W_QB); const bf16_t* Qbr = (const bf16_t*)(ws + W_QBR); const bf16_t* Kb = (const bf16_t*)(ws + W_KB); const bf16_t* VbT = (const bf16_t*)(ws + W_VBT);
    bf16_t* Y = (bf16_t*)(ws + W_Y);
    const float scA = 0.08838834764831845f * LOG2E, scB = 0.125f * LOG2E;
    const float* subln = p.in[I_SUBLN] + l * 128;
    PG8_LAS int* s_item = (PG8_LAS int*)(lds + ATT_LDS_BYTES);
#if STATIC_Q
    for (int idx0 = BIDX(); idx0 < N_MIX; idx0 += gridDim.x) {
        int idx = idx0;
#else
    for (;;) {
        if (tid == 0) *s_item = (int)atomicAdd(cnt, 1u);
        __syncthreads();
        int idx = *s_item;
        __syncthreads();
        if (idx >= N_MIX) break;
#endif
        const int tid2 = TIDX(), l16 = tid2 & 15, wv = tid2 >> 6;
#if PROBE
        if (tid == 0 && l == 0) {
            unsigned long long* ts = (unsigned long long*)(p.ws + W_CNT + 2048);
            if (idx == N_BL) ts[42] = wall_clock64();
            if (idx == N_BL + N_AL) ts[43] = wall_clock64();
            if (idx == N_BL + N_AL + N_M3) ts[44] = wall_clock64();
        }
#endif
        if (idx < N_BL) {
            const int b = idx / 80, h = (idx % 80) / 16, qb = idx % 16;
            const int tl = b * 2048 + qb * 128 + wv * 16 + l16, t = TC + tl;
            attn_block<true, false>(lds, Qbr + (size_t)tl * 640 + h * 128, Qb + (size_t)t * 640 + h * 128,
                             Kb + (size_t)(TC + b * 2048) * 640 + h * 128, 640, 0, 32, VbT + LATV_B + (size_t)(b * 5 + h) * 128 * 2048, 2048,
                             (const bf16_t*)(ws + W_CKB) + (size_t)((b * 2 + l) * 5 + h) * 65536, 128, 8, (const bf16_t*)(ws + W_CVB) + (size_t)((b * 2 + l) * 5 + h) * 65536, 512,
                             0, 0, 0, 0, 0, nullptr, scB, Y + (size_t)t * D + 768 + h * 128, lam, subln, 1.0f - lam_init);
            continue;
        }
        idx -= N_BL;
        if (idx < N_AL) {
            const int b = idx / 96, h = (idx % 96) / 16, rp = idx % 16;
            const int r0 = 2 * rp, r = r0 + (wv >> 2), q4 = wv & 3;
            const int qc0 = 16 * q4, c0 = clampi(qc0 - 8, 0, 32), rs = clampi(r - 4, 0, 24), rsmin = clampi(r0 - 4, 0, 24), rsmax = clampi(r0 + 1 - 4, 0, 24);
            const int t = TC + b * 2048 + r * 64 + qc0 + l16;
            const bf16_t* qrow = Qa + (size_t)t * 768 + h * 128;
            attn_block<false, true>(lds, qrow, qrow, Ka + (size_t)(TC + b * 2048) * 768 + h * 128, 768, rsmin * 64, rsmax + 8 - rsmin, VaT + LATV_A + (size_t)(b * 6 + h) * 128 * 2048, 2048,
                              (const bf16_t*)(ws + W_CKA) + (size_t)((b * 2 + l) * 6 + h) * 65536, 128, 8, (const bf16_t*)(ws + W_CVA) + (size_t)((b * 2 + l) * 6 + h) * 65536, 512,
                              r, qc0, c0, rs, rsmin, p.in[I_RPB] + (size_t)(l * 6 + h) * 465, scA, Y + (size_t)t * D + h * 128, 0.f, nullptr, 1.0f);
            continue;
        }
        idx -= N_AL;
        if (idx < N_M3) { m3_item(p, l, idx * 8 + wv); continue; }
        idx -= N_M3;
        if (idx < N_AC) {
            const int b = idx / 12, h = (idx % 12) / 2, qb = idx % 2;
            const int t = b * 256 + qb * 128 + wv * 16 + l16;
            const bf16_t* qrow = Qa + (size_t)t * 768 + h * 128;
            attn_block<false, false>(lds, qrow, qrow, Ka + (size_t)(b * 256) * 768 + h * 128, 768, 0, 4, VaT + (size_t)(b * 6 + h) * 128 * 256, 256,
                              nullptr, 0, 0, nullptr, 0, 0, 0, 0, 0, 0, nullptr, scA, Y + (size_t)t * D + h * 128, 0.f, nullptr, 1.0f);
            continue;
        }
        idx -= N_AC;
        {
            const int b = idx / 10, h = (idx % 10) / 2, qb = idx % 2;
            const int t = b * 256 + qb * 128 + wv * 16 + l16;
            const bf16_t* qrow = Qb + (size_t)t * 640 + h * 128;
            attn_block<true, false>(lds, qrow, qrow, Kb + (size_t)(b * 256) * 640 + h * 128, 640, 0, 4, VbT + (size_t)(b * 5 + h) * 128 * 256, 256,
                             nullptr, 0, 0, nullptr, 0, 0, 0, 0, 0, 0, nullptr, scB, Y + (size_t)t * D + 768 + h * 128, lam, subln, 1.0f - lam_init);
        }
    }
}

#define XB_TMO      128
#define XB_XCNT(j)  (256  + 64 * (j))
#define XB_XSUB(j)  (1280 + 64 * (j))
#define XB_XGEN(j)  (2304 + 64 * (j))
#define XB_TOP      3328
#define XB_TOPGEN   3392
#define XB_SPIN_CAP (1u << 18)
DEVI unsigned xb_ld(unsigned* p) { return __hip_atomic_load(p, __ATOMIC_RELAXED, __HIP_MEMORY_SCOPE_AGENT); }
DEVI unsigned xb_add(unsigned* p, unsigned v) { return __hip_atomic_fetch_add(p, v, __ATOMIC_RELAXED, __HIP_MEMORY_SCOPE_AGENT); }
DEVI unsigned xb_xcc_id() { return (unsigned)__builtin_amdgcn_s_getreg((3 << 11) | 20) & 0xFu; }
#define XB_SPIN(cond, bar) do { unsigned _sp = 0; while (cond) { \
    if ((++_sp & 255u) == 0u) { if (xb_ld(&(bar)[XB_TMO])) break; if (_sp > XB_SPIN_CAP) { atomicAdd(&(bar)[XB_TMO], 1u); break; } } } } while (0)
struct XcdBarrier { unsigned* bar; unsigned x; volatile PG8_LAS unsigned* st; };
DEVI void xcd_barrier_complete(unsigned* bar, unsigned x, unsigned& nloc, unsigned& nx) {
    const unsigned G = gridDim.x;
    unsigned sum, cnt, mine, sp = 0u;
    for (;;) {
        sum = 0u; cnt = 0u; mine = 0u;
#pragma unroll
        for (unsigned j = 0; j < 16; ++j) { const unsigned c = xb_ld(&bar[XB_XCNT(j)]); sum += c; cnt += (c > 0u) ? 1u : 0u; mine = (j == x) ? c : mine; }
        if (sum == G) break;
        __builtin_amdgcn_s_sleep(1);
        if ((++sp & 255u) == 0u) { if (xb_ld(&bar[XB_TMO])) break; if (sp > XB_SPIN_CAP) { atomicAdd(&bar[XB_TMO], 1u); break; } }
    }
    nloc = mine > 0u ? mine : 1u; nx = cnt > 0u ? cnt : 1u;
}
DEVI void xcd_barrier(const XcdBarrier& b) {
    asm volatile("s_waitcnt vmcnt(0) lgkmcnt(0)" ::: "memory");
    __syncthreads();
    if (threadIdx.x == 0) {
        unsigned* bar = b.bar;
        __builtin_amdgcn_s_waitcnt(0);
        unsigned nloc = b.st[0], nx = b.st[1];
        if (nloc == 0u) { xcd_barrier_complete(bar, b.x, nloc, nx); b.st[0] = nloc; b.st[1] = nx; }
        const unsigned old = xb_add(&bar[XB_XSUB(b.x)], 1u);
        const unsigned gen = old / nloc;
        if (old + 1u == (gen + 1u) * nloc) {
            __builtin_amdgcn_fence(__ATOMIC_RELEASE, "agent");
            asm volatile("s_waitcnt vmcnt(0)" ::: "memory");
            const unsigned og = xb_add(&bar[XB_TOP], 1u);
            const unsigned tg = og / nx;
            if (og + 1u == (tg + 1u) * nx) xb_add(&bar[XB_TOPGEN], 1u);
            else XB_SPIN(xb_ld(&bar[XB_TOPGEN]) == tg, bar);
            __builtin_amdgcn_fence(__ATOMIC_ACQUIRE, "agent");
            xb_add(&bar[XB_XGEN(b.x)], 1u);
            asm volatile("s_waitcnt vmcnt(0)" ::: "memory");
        } else {
            XB_SPIN(xb_ld(&bar[XB_XGEN(b.x)]) == gen, bar);
            __builtin_amdgcn_fence(__ATOMIC_ACQUIRE, "agent");
            asm volatile("s_waitcnt vmcnt(0)" ::: "memory");
        }
    }
    __syncthreads();
}
#define gsync(G) xcd_barrier(xb)
constexpr int NPHASE = 19;
#ifndef PH_END
#define PH_END NPHASE
#endif
DEVI int kind_of_phase(int ph) {
    if (ph < 3) return ph;
    const int k = (ph - 3) % 8;
    return k == 0 ? 3 : k == 1 ? 4 : k == 2 ? 5 : k == 3 ? 6 : (k == 4 || k == 7) ? 7 : k == 5 ? 9 : 10;
}
template <unsigned MASK>
__global__ __launch_bounds__(512, 2) void fwd_kernel(P p) {
    extern __shared__ __attribute__((aligned(16))) unsigned char shm[];
    cg::grid_group grid = cg::this_grid();
    PG8_LAS unsigned char* lds = (PG8_LAS unsigned char*)shm;
    if (p.ph_lo < 0) grid.sync();
    volatile PG8_LAS unsigned* xst = (volatile PG8_LAS unsigned*)(lds + 131072);
    if (threadIdx.x == 0) { xst[0] = 0u; xst[1] = 0u; }
    __syncthreads();
    XcdBarrier xb; xb.bar = (unsigned*)(p.ws + W_BAR); xb.x = xb_xcc_id(); xb.st = xst;
    if (threadIdx.x == 0) (void)xb_add(&xb.bar[XB_XCNT(xb.x)], 1u);
#if PROBE
    unsigned long long* ts = (unsigned long long*)(p.ws + W_CNT + 2048);
    if (blockIdx.x == 0 && threadIdx.x == 0) ts[40] = wall_clock64();
    gsync(grid);
    if (blockIdx.x == 0 && threadIdx.x == 0) ts[41] = wall_clock64();
    gsync(grid);
    if (blockIdx.x == 0 && threadIdx.x == 0) ts[0] = wall_clock64();
#endif
    for (int ph = p.ph_lo; ph < p.ph_hi; ++ph) {
        char* ws = WSP(p.ws);
        const int kind = kind_of_phase(ph);
        const int l = ph < 3 ? 0 : (ph - 3) / 8, k = ph < 3 ? 0 : (ph - 3) % 8;
        const float* mods = (const float*)(ws + W_MODS) + (size_t)l * 36864;
        pg8::StaticOrder S;
        if constexpr ((MASK >> 0) & 1) if (kind == 0) phase0a(p, (float*)shm);
        if constexpr ((MASK >> 1) & 1) if (kind == 1) phase0b(p);
        if constexpr ((MASK >> 2) & 1) if (kind == 2) phase0c(p);
        if constexpr ((MASK >> 3) & 1) if (kind == 3) {
            pg8::Gemm g{(const bf16_t*)(ws + W_H), (const bf16_t*)(ws + W_WIN) + (size_t)l * NINP * D, T, NINP, D};
            S.init(T, NINP, (int)gridDim.x, (int)BIDX());
            EpiIn E{ws, p.out, p.in[I_GATEB], l};
            pg8::gemm_phase<EpiIn, pg8::StaticOrder>(lds, g, S, E);
            if ((int)BIDX() >= 96) weight_units(p, l, 280, 816, (int)BIDX() - 96, (int)gridDim.x - 96, (float*)shm);
        }
        if constexpr ((MASK >> 4) & 1) if (kind == 4) {
            for (int it = BIDX() * 8 + (TIDX() >> 6); it < 1280; it += gridDim.x * 8) m1_item(p, it);
        }
        if constexpr ((MASK >> 5) & 1) if (kind == 5) m2_phase(p, l);
        if constexpr ((MASK >> 6) & 1) if (kind == 6) mixer_phase(p, l, lds);
        if constexpr ((MASK >> 7) & 1) if (kind == 7) {
            float* stats = (float*)(ws + W_MODP);
            unsigned* lncnt = (unsigned*)(ws + W_CNT) + 256;
            const bool last = l == 1;
            if (k == 4) {
                pg8::Gemm g{(const bf16_t*)(ws + W_Y), (const bf16_t*)(ws + W_WOUT) + (size_t)l * D * D, T, D, D};
                S.init(T, D, (int)gridDim.x, (int)BIDX());
                EpiResLN E{l == 0 ? p.in[I_XP] : (const float*)(ws + W_X), l == 0 ? p.in[I_XS] : (const float*)(ws + W_X) + (size_t)TC * XS, (float*)(ws + W_X), mods + 2 * 2048,
                           p.in[I_LN1G] + l * D, p.in[I_LN1B] + l * D, mods + 3 * 2048, (bf16_t*)(ws + W_H), stats + (size_t)(l * 2) * 32 * 256 * 16, lncnt + (l * 2) * 32, l == 0 ? D : XS, XS};
                pg8::gemm_phase<EpiResLN, pg8::StaticOrder>(lds, g, S, E);
            } else {
                pg8::Gemm g{(const bf16_t*)(ws + W_ACT), (const bf16_t*)(ws + W_WDN) + (size_t)l * D * DFF, T, D, DFF};
                S.init(T, D, (int)gridDim.x, (int)BIDX());
                EpiResLN E{(const float*)(ws + W_X), (const float*)(ws + W_X) + (size_t)TC * XS, last ? p.out + O_Y : (float*)(ws + W_X), mods + 5 * 2048,
                           p.in[I_LN2G] + l * D, p.in[I_LN2B] + l * D, last ? nullptr : mods + 36864, (bf16_t*)(ws + W_H), stats + (size_t)(l * 2 + 1) * 32 * 256 * 16, lncnt + (l * 2 + 1) * 32, XS, last ? D : XS};
                pg8::gemm_phase<EpiResLN, pg8::StaticOrder>(lds, g, S, E);
            }
        }
        if constexpr ((MASK >> 9) & 1) if (kind == 9) {
            pg8::Gemm g{(const bf16_t*)(ws + W_H), (const bf16_t*)(ws + W_WUP) + (size_t)l * NUP * D, T, NUP, D};
            S.init(T, NUP, (int)gridDim.x, (int)BIDX());
            EpiU E{(bf16_t*)(ws + W_U)};
            pg8::gemm_phase<EpiU, pg8::StaticOrder>(lds, g, S, E);
            if (l == 0 && (int)BIDX() >= 96) weight_units(p, 1, 0, 280, (int)BIDX() - 96, (int)gridDim.x - 96, (float*)shm);
        }
        if constexpr ((MASK >> 10) & 1) if (kind == 10) conv_phase(p, l);
#if PROBE
        gsync(grid);
        if (blockIdx.x == 0 && threadIdx.x == 0) ts[ph + 1] = wall_clock64();
#else
        if (ph + 1 < p.ph_hi) gsync(grid);
#endif
    }
#if CMP
    gsync(grid);
    if (blockIdx.x == 0) {
        const unsigned* cw = (const unsigned*)(p.ws + W_CNT);
        const size_t offs[8] = {O_Y, O_Y + 8388608, O_AK, O_AV, O_BK, O_BV, O_CC, O_CN};
        for (int c = 0; c < 8; ++c) {
            const unsigned m = __hip_atomic_load(cw + 128 + c, __ATOMIC_RELAXED, __HIP_MEMORY_SCOPE_AGENT);
            const int n = m == 0 ? 0 : (m < 1000 ? 10 : (m < 20000 ? 100 : 1000));
            unsigned* o = (unsigned*)p.out + offs[c];
            for (int i = threadIdx.x; i < n; i += 512) o[i] = 0xAAAAAAAAu;
        }
    }
#endif
#if PROBE
    if (blockIdx.x == 0) {
        __syncthreads();
        const size_t offs[9] = {O_Y, O_Y + 8388608, O_AK, O_AV, O_BK, O_BV, O_CC, O_CN, O_CM};
#if PROBE == 1
        const int ta[9] = {0, 3, 4, 6, 7, 8, 9, 0, 0}, tb[9] = {3, 4, 6, 7, 8, 9, 10, 0, 0};
        const int dv[9] = {400, 400, 400, 400, 400, 400, 400, 100, 100};
#elif PROBE == 4
        const int ta[9] = {3, 4, 6, 7, 8, 9, 10, 0, 0}, tb[9] = {4, 6, 7, 8, 9, 10, 11, 0, 0};
        const int dv[9] = {400, 400, 400, 400, 400, 400, 400, 100, 100};
#elif PROBE == 5
        const int ta[9] = {0, 45, 1, 2, 4, 5, 9, 0, 0}, tb[9] = {45, 1, 2, 3, 5, 6, 10, 0, 0};
        const int dv[9] = {400, 400, 400, 400, 400, 400, 400, 100, 100};
#elif PROBE == 3
        const int ta[9] = {10, 11, 12, 0, 1, 2, 5, 0, 0}, tb[9] = {11, 12, 13, 1, 2, 3, 6, 0, 0};
        const int dv[9] = {400, 400, 400, 400, 400, 400, 400, 100, 100};
#else
        const int ta[9] = {40, 0, 4, 5, 6, 6, 6, 0, 0}, tb[9] = {41, 1, 5, 6, 42, 43, 44, 0, 0};
        const int dv[9] = {40, 400, 400, 400, 400, 400, 400, 100, 100};
#endif
        for (int c = 0; c < 9; ++c) {
            long long d = (long long)(ts[tb[c]] - ts[ta[c]]) / dv[c];
            int n = (int)d; if (c == 8 && n > 320) n = 320; if (c == 7 && n > 40960) n = 40960;
            unsigned* o = (unsigned*)p.out + offs[c];
            for (int i = threadIdx.x; i < n; i += 512) o[i] = 0xAAAAAAAAu;
        }
    }
#endif
}

static int host_kind_of_phase(int ph) {
    if (ph < 3) return ph;
    const int k = (ph - 3) % 8;
    return k == 0 ? 3 : k == 1 ? 4 : k == 2 ? 5 : k == 3 ? 6 : (k == 4 || k == 7) ? 7 : k == 5 ? 9 : 10;
}
typedef void (*kern_t)(P);
extern "C" void kernel_launch(void* const* d_in, const int* in_sizes, int n_in, void* d_out, int out_size, void* d_ws, size_t ws_size, hipStream_t stream) {
    constexpr size_t kDynLds = 131072 + 16;
    static int grid_blocks = 0;
#if ONE_LAUNCH
    static kern_t kerns[1] = {fwd_kernel<0x7ffu>};
    constexpr int NK = 1;
#else
    static kern_t kerns[11] = {fwd_kernel<1u>, fwd_kernel<2u>, fwd_kernel<4u>, fwd_kernel<8u>, fwd_kernel<16u>, fwd_kernel<32u>, fwd_kernel<64u>, fwd_kernel<128u>, fwd_kernel<256u>, fwd_kernel<512u>, fwd_kernel<1024u>};
    constexpr int NK = 11;
#endif
    if (!grid_blocks) {
        int dev = 0, cus = 0, per_cu = 8;
        (void)hipGetDevice(&dev);
        (void)hipDeviceGetAttribute(&cus, hipDeviceAttributeMultiprocessorCount, dev);
        for (int i = 0; i < NK; ++i) {
            int pc = 0;
            (void)hipFuncSetAttribute((const void*)kerns[i], hipFuncAttributeMaxDynamicSharedMemorySize, (int)kDynLds);
            (void)hipOccupancyMaxActiveBlocksPerMultiprocessor(&pc, kerns[i], 512, kDynLds);
            if (pc < per_cu) per_cu = pc;
        }
        if (per_cu < 1) per_cu = 1;
        grid_blocks = cus * per_cu;
        if (ws_size < W_END) fprintf(stderr, "workspace too small: %zu < %zu\n", ws_size, (size_t)W_END);
    }
    P p{};
    for (int i = 0; i < 28; ++i) p.in[i] = (const float*)d_in[i];
    p.out = (float*)d_out;
    p.ws = (char*)d_ws;
    (void)hipMemsetAsync((char*)d_ws + W_CNT, 0, 32768, stream);
#if ONE_LAUNCH
    p.ph_lo = 0; p.ph_hi = NPHASE;
    void* args[] = {&p};
    hipError_t e = hipLaunchCooperativeKernel((const void*)kerns[0], dim3(grid_blocks), dim3(512), args, kDynLds, stream);
    if (e != hipSuccess) fprintf(stderr, "cooperative launch failed: %s (grid %d)\n", hipGetErrorString(e), grid_blocks);
#else
    for (int ph = 0; ph < PH_END; ++ph) {
        p.ph_lo = ph; p.ph_hi = ph + 1;
        hipLaunchKernelGGL(kerns[host_kind_of_phase(ph)], dim3(grid_blocks), dim3(512), kDynLds, stream, p);
    }
#endif
}
```

```cpp
#include <hip/hip_runtime.h>
#include <hip/hip_cooperative_groups.h>
#include <cstdio>
namespace cg = cooperative_groups;

#define DEVI __device__ __forceinline__
typedef unsigned short bf16_t;
typedef short bf16x8 __attribute__((ext_vector_type(8)));
typedef float f32x4 __attribute__((ext_vector_type(4)));
typedef unsigned u32x4 __attribute__((ext_vector_type(4)));
typedef unsigned u32x2 __attribute__((ext_vector_type(2)));

constexpr int D = 2048, T = 8192, TC = 4096, NIN = 6804, NINP = 6912, DFF = 5504, NUP = 11008;
constexpr float ALPHA = 1.4142135623730951f;
constexpr float LOG2E = 1.4426950408889634f;

constexpr size_t O_Y = 0, O_AK = 16777216, O_AV = 23068672, O_BK = 29360128, O_BV = 34603008, O_CC = 39845888, O_CN = 45088768, O_CM = 45129728;

constexpr size_t al256(size_t x) { return (x + 255) & ~(size_t)255; }
constexpr size_t W_CNT = 0;
constexpr size_t W_BAR = 8192;
constexpr size_t W_WIN = 32768;
constexpr size_t W_WOUT = W_WIN + (size_t)2 * NINP * D * 2;
constexpr size_t W_WUP = W_WOUT + (size_t)2 * D * D * 2;
constexpr size_t W_WDN = W_WUP + (size_t)2 * NUP * D * 2;
constexpr size_t W_MODP = W_WDN + (size_t)2 * D * DFF * 2;
constexpr size_t W_MODS = W_MODP + (size_t)2 * 16 * 3 * 12288 * 4;
constexpr size_t W_ROPE = W_MODS + (size_t)2 * 3 * 12288 * 4;
constexpr size_t W_CKA = W_ROPE + 8192;
constexpr size_t W_CVA = W_CKA + (size_t)24 * 65536 * 2;
constexpr size_t W_CKB = W_CVA + (size_t)24 * 65536 * 2;
constexpr size_t W_CVB = W_CKB + (size_t)20 * 65536 * 2;
constexpr size_t W_X = W_CVB + (size_t)20 * 65536 * 2;
constexpr int XS = 2112;
constexpr size_t W_H = W_X + (size_t)T * XS * 4;
constexpr size_t W_R = W_H + (size_t)T * D * 2;
constexpr size_t SZA = (size_t)T * 768 * 2, SZB = (size_t)T * 640 * 2;
constexpr size_t W_QA = W_R, W_KA = W_QA + SZA, W_VAT = W_KA + SZA;
constexpr size_t W_QB = W_VAT + SZA, W_QBR = W_QB + SZB, W_KB = W_QBR + SZB / 2, W_VBT = W_KB + SZB;
constexpr size_t W_QC = W_VBT + SZB, W_KC = W_QC + SZB, W_KCT = W_KC + SZB, W_VCT = W_KCT + SZB, W_OG = W_VCT + SZB;
constexpr size_t W_G = W_OG + SZB;
constexpr size_t W_Y = W_G + (size_t)T * 20 * 4;
constexpr size_t W_ST = W_Y + (size_t)T * D * 2;
constexpr size_t W_SN = W_ST + (size_t)1920 * 16384 * 4;
constexpr size_t W_SS = W_SN + (size_t)1920 * 128 * 4;
constexpr size_t W_REND = W_SS + (size_t)3 * 1920 * 4;
constexpr size_t W_MODP2 = W_R;
constexpr size_t W_U = W_R;
constexpr size_t W_UEND = W_U + (size_t)T * NUP * 2;
constexpr size_t W_ACT = al256(W_REND > W_UEND ? W_REND : W_UEND);
constexpr size_t W_END = W_ACT + (size_t)T * DFF * 2;

struct P {
    const float* in[28];
    float* out;
    char* ws;
    int ph_lo, ph_hi;
};
enum { I_XP = 0, I_XS, I_CAK, I_CAV, I_CBK, I_CBV, I_SC, I_SN, I_SM, I_C, I_CCTX, I_WMOD, I_BMOD, I_WIN, I_GATEB, I_RPB, I_LAMBDA, I_SUBLN, I_CNORM, I_WOUT,
       I_LN1G, I_LN1B, I_LN2G, I_LN2B, I_WUP, I_CONVW, I_CONVB, I_WDN };

DEVI float bf2f(bf16_t v) { return __uint_as_float(((unsigned)v) << 16); }
DEVI float bflo(unsigned u) { return __uint_as_float(u << 16); }
DEVI float bfhi(unsigned u) { return __uint_as_float(u & 0xffff0000u); }
DEVI float wave_sum(float v) {
#pragma unroll
    for (int o = 32; o > 0; o >>= 1) v += __shfl_xor(v, o);
    return v;
}
DEVI float wave_max(float v) {
#pragma unroll
    for (int o = 32; o > 0; o >>= 1) v = fmaxf(v, __shfl_xor(v, o));
    return v;
}
DEVI float sigmoidf_(float x) { return __builtin_amdgcn_rcpf(1.0f + __expf(-x)); }
DEVI float siluf_(float x) { return x * __builtin_amdgcn_rcpf(1.0f + __expf(-x)); }

DEVI int TIDX() { int t = threadIdx.x; asm volatile("" : "+v"(t)); return t; }
DEVI int BIDX() { int b = blockIdx.x; asm volatile("" : "+s"(b)); return b; }
DEVI char* WSP(char* w) { asm volatile("" : "+s"(w)); return w; }
#define ONE_LAUNCH 1
namespace pg8 {
#define PG8_LAS __attribute__((address_space(3)))
typedef unsigned short bf16_t;
typedef short bf16x8 __attribute__((ext_vector_type(8)));
typedef float f32x4 __attribute__((ext_vector_type(4)));
typedef unsigned u32x4 __attribute__((ext_vector_type(4)));
constexpr int BM = 256, BK = 64, HALF = 128, HTB = HALF * BK * 2  , STAGE_BYTES = 8 * HTB, NXCD = 8, WGM = 4;

__host__ __device__ __forceinline__ int lds_byte(int r, int c) { const int st = (r >> 4) * 2 + (c >> 5), rr = r & 15, cc = c & 31, ob = rr * 64 + cc * 2; return st * 1024 + (ob ^ (((ob >> 9) & 1) << 5)); }
__host__ __device__ __forceinline__ void stage_rc(int b, int& R, int& C) { const int st = b / 1024, sb = b % 1024, swz = sb ^ (((sb >> 9) & 1) << 5); R = (st >> 1) * 16 + swz / 64; C = (st & 1) * 32 + (swz % 64) / 2; }
__host__ __device__ __forceinline__ int perm32(int rho) { const int n = rho >> 4, i = rho & 15; return 8 * (i >> 2) + 4 * n + (i & 3); }

struct Unit { int pm, pn; };
struct Gemm { const bf16_t* A; const bf16_t* Bt; int M, N, K; };

struct StaticOrder {
    int nM, nN, nwg, G, c;
    __host__ __device__ __forceinline__ void init(int M, int N, int G_, int c_) { nM = M / BM; nN = N / BM; nwg = nM * nN; G = G_; c = c_; }
    __host__ __device__ __forceinline__ bool next(int i, Unit& u) const {
        const long L = (long)i * G + c; if (L >= nwg) return false;
        int wgid = (int)L; { const int q = nwg / NXCD, r = nwg % NXCD, xcd = wgid % NXCD, off = wgid / NXCD; wgid = (xcd < r ? xcd * (q + 1) : r * (q + 1) + (xcd - r) * q) + off; }
        const int nig = WGM * nN, gid = wgid / nig, fm = gid * WGM, gsz = (nM - fm) < WGM ? (nM - fm) : WGM;
        u.pm = fm + ((wgid % nig) % gsz); u.pn = (wgid % nig) / gsz; return true;
    }
    __device__ __forceinline__ void a_ready(const Unit&) const {}
    __device__ __forceinline__ void done(const Unit&) const {}
};
__device__ __forceinline__ unsigned cvt_pk_bf16(float lo, float hi) { unsigned r; asm volatile("v_cvt_pk_bf16_f32 %0, %1, %2" : "=v"(r) : "v"(lo), "v"(hi)); return r; }
template <class Epi, class Sched>
__device__ __forceinline__ void gemm_phase(PG8_LAS unsigned char* lds, const Gemm g, const Sched& S, const Epi& E) {
    const int tid = TIDX(), wid = __builtin_amdgcn_readfirstlane(tid >> 6), lane = tid & 63, wr = wid >> 2, wc = wid & 3, fr = lane & 15, fq = lane >> 4;
    const int K = g.K, nt = K / BK;
    unsigned voffA[2], voffB[2];
#pragma unroll
    for (int i = 0; i < 2; ++i) { int R, C; stage_rc(tid * 16 + i * 8192, R, C); const int Rb = Epi::PERM ? ((R & ~31) + perm32(R & 31)) : R;
        voffA[i] = (unsigned)(R * K + C) * 2u; voffB[i] = (unsigned)(Rb * K + C) * 2u; }
    const size_t kstep = (size_t)(BK * 2);
    const size_t hstep = (size_t)HALF * K * 2;
    const size_t tstep = 2 * hstep;
    const unsigned ldsw = (unsigned)wid * 1024u;
    const int aoff = lds_byte(wr * 64 + fr, fq * 8), boff = lds_byte(wc * 32 + fr, fq * 8);
#define PG8_SA(b, h) (((b) * 2 + (h)) * HTB)
#define PG8_SB(b, h) ((4 + (b) * 2 + (h)) * HTB)
#define PG8_STAGE(bufoff, gbase, voff) do { _Pragma("unroll") for (int _i = 0; _i < 2; ++_i) \
        __builtin_amdgcn_global_load_lds((const unsigned*)((const char*)(gbase) + (voff)[_i]), (PG8_LAS unsigned*)(lds + (bufoff) + ldsw + _i * 8192), 16, 0, 0); } while (0)
#define PG8_LDA(dst, b, h) do { _Pragma("unroll") for (int m = 0; m < 4; ++m) _Pragma("unroll") for (int k = 0; k < 2; ++k) dst[m][k] = *(const PG8_LAS bf16x8*)(lds + PG8_SA(b, h) + aoff + m * 2048 + k * 1024); } while (0)
#define PG8_LDB(dst, b, h) do { _Pragma("unroll") for (int n = 0; n < 2; ++n) _Pragma("unroll") for (int k = 0; k < 2; ++k) dst[n][k] = *(const PG8_LAS bf16x8*)(lds + PG8_SB(b, h) + boff + n * 2048 + k * 1024); } while (0)
#define PG8_MMA(ai, bj, At, Bt) do { __builtin_amdgcn_s_setprio(1); _Pragma("unroll") for (int m = 0; m < 4; ++m) _Pragma("unroll") for (int n = 0; n < 2; ++n) _Pragma("unroll") for (int k = 0; k < 2; ++k) \
        acc[ai][bj][m][n] = __builtin_amdgcn_mfma_f32_16x16x32_bf16(Bt[n][k], At[m][k], acc[ai][bj][m][n], 0, 0, 0); __builtin_amdgcn_s_setprio(0); } while (0)
#define PG8_WAIT_V(n) asm volatile("s_waitcnt vmcnt(" #n ")" ::: "memory")
#define PG8_WAIT_L(n) asm volatile("s_waitcnt lgkmcnt(" #n ")" ::: "memory")
#define PG8_BAR __builtin_amdgcn_s_barrier()
#define PG8_SCHED __builtin_amdgcn_sched_barrier(0)
    Unit cur, nxt; int ui = 0;
    if (!S.next(0, cur)) return;
    f32x4 acc[2][2][4][2];
#pragma unroll
    for (int a = 0; a < 2; ++a)
#pragma unroll
        for (int b = 0; b < 2; ++b)
#pragma unroll
            for (int m = 0; m < 4; ++m)
#pragma unroll
                for (int n = 0; n < 2; ++n) acc[a][b][m][n] = (f32x4){0.f, 0.f, 0.f, 0.f};
    bf16x8 At[4][2], B0[2][2], B1[2][2];
    const char* cA = (const char*)g.A + (size_t)cur.pm * tstep; const char* cB = (const char*)g.Bt + (size_t)cur.pn * tstep;
    S.a_ready(cur);
    PG8_STAGE(PG8_SB(0, 0), cB, voffB); PG8_STAGE(PG8_SA(0, 0), cA, voffA); PG8_STAGE(PG8_SB(0, 1), cB + hstep, voffB); PG8_STAGE(PG8_SA(0, 1), cA + hstep, voffA);
    if (wr == 1) PG8_BAR;
    PG8_WAIT_V(4); PG8_BAR;
    PG8_STAGE(PG8_SB(1, 0), cB + kstep, voffB); PG8_STAGE(PG8_SA(1, 0), cA + kstep, voffA); PG8_STAGE(PG8_SB(1, 1), cB + hstep + kstep, voffB);
    PG8_WAIT_V(6); PG8_BAR;
    for (;;) {
        const bool has_next = S.next(ui + 1, nxt);
        const char* nA = has_next ? (const char*)g.A + (size_t)nxt.pm * tstep : cA; const char* nB = has_next ? (const char*)g.Bt + (size_t)nxt.pn * tstep : cB;
        for (int t = 0; t < nt; t += 2) {
            const bool last = (t == nt - 2);
            const char* a1 = cA + (size_t)(t + 1) * kstep;
            const char* a2 = last ? nA : cA + (size_t)(t + 2) * kstep; const char* b2 = last ? nB : cB + (size_t)(t + 2) * kstep;
            const char* a3 = a2 + kstep; const char* b3 = b2 + kstep;
            if (last && has_next) S.a_ready(nxt);
            PG8_LDB(B0, 0, 0); PG8_SCHED; PG8_LDA(At, 0, 0); PG8_STAGE(PG8_SA(1, 1), a1 + hstep, voffA);
            PG8_WAIT_L(8); PG8_BAR; PG8_WAIT_L(0); PG8_MMA(0, 0, At, B0); PG8_BAR; PG8_SCHED;
            PG8_LDB(B1, 0, 1); PG8_STAGE(PG8_SB(0, 0), b2, voffB);
            PG8_BAR; PG8_WAIT_L(0); PG8_MMA(0, 1, At, B1); PG8_BAR;
            PG8_LDA(At, 0, 1); PG8_STAGE(PG8_SA(0, 0), a2, voffA);
            PG8_BAR; PG8_WAIT_L(0); PG8_MMA(1, 0, At, B0); PG8_BAR; PG8_SCHED;
            PG8_STAGE(PG8_SB(0, 1), b2 + hstep, voffB);
            PG8_WAIT_V(6); PG8_BAR; PG8_MMA(1, 1, At, B1); PG8_BAR;
            PG8_LDB(B0, 1, 0); PG8_SCHED; PG8_LDA(At, 1, 0); PG8_STAGE(PG8_SA(0, 1), a2 + hstep, voffA);
            PG8_WAIT_L(8); PG8_BAR; PG8_WAIT_L(0); PG8_MMA(0, 0, At, B0); PG8_BAR; PG8_SCHED;
            PG8_LDB(B1, 1, 1); PG8_STAGE(PG8_SB(1, 0), b3, voffB);
            PG8_BAR; PG8_WAIT_L(0); PG8_MMA(0, 1, At, B1); PG8_BAR;
            PG8_LDA(At, 1, 1); PG8_STAGE(PG8_SA(1, 0), a3, voffA);
            PG8_BAR; PG8_WAIT_L(0); PG8_MMA(1, 0, At, B0); PG8_BAR; PG8_SCHED;
            PG8_STAGE(PG8_SB(1, 1), b3 + hstep, voffB);
            PG8_WAIT_V(6); PG8_BAR; PG8_MMA(1, 1, At, B1); PG8_BAR;
        }
        if constexpr (!Epi::AFTER_DRAIN) { E(acc, cur, wr, wc, fr, fq); S.done(cur); }
        if (!has_next) break;
#pragma unroll
        for (int a = 0; a < 2; ++a)
#pragma unroll
            for (int b = 0; b < 2; ++b)
#pragma unroll
                for (int m = 0; m < 4; ++m)
#pragma unroll
                    for (int n = 0; n < 2; ++n) acc[a][b][m][n] = (f32x4){0.f, 0.f, 0.f, 0.f};
        cur = nxt; cA = nA; cB = nB; ++ui;
    }
    PG8_WAIT_V(0);
    if (wr == 0) PG8_BAR;
    PG8_BAR;
    if constexpr (Epi::AFTER_DRAIN) { E.fused(acc, cur, wr, wc, fr, fq, lds, wid, lane); S.done(cur); }
#undef PG8_SA
#undef PG8_SB
#undef PG8_STAGE
#undef PG8_LDA
#undef PG8_LDB
#undef PG8_MMA
#undef PG8_WAIT_V
#undef PG8_WAIT_L
#undef PG8_BAR
#undef PG8_SCHED
}
}

using pg8::cvt_pk_bf16;
DEVI bf16x8 ld8(const bf16_t* p) { return *(const bf16x8*)p; }
DEVI bf16x8 ld4x2(const bf16_t* p0, const bf16_t* p1) {
    const u32x2 a = *(const u32x2*)p0, b = *(const u32x2*)p1;
    const u32x4 r = {a[0], a[1], b[0], b[1]};
    return __builtin_bit_cast(bf16x8, r);
}
DEVI bf16x8 pack8(f32x4 a, f32x4 b) {
    const u32x4 r = {cvt_pk_bf16(a[0], a[1]), cvt_pk_bf16(a[2], a[3]), cvt_pk_bf16(b[0], b[1]), cvt_pk_bf16(b[2], b[3])};
    return __builtin_bit_cast(bf16x8, r);
}
DEVI void st4(bf16_t* p, f32x4 v) { const u32x2 r = {cvt_pk_bf16(v[0], v[1]), cvt_pk_bf16(v[2], v[3])}; *(u32x2*)p = r; }
DEVI bf16_t f2bf1(float f) { return (bf16_t)(cvt_pk_bf16(f, 0.f) & 0xffffu); }
DEVI f32x4 mfma16(bf16x8 a, bf16x8 b, f32x4 c) { return __builtin_amdgcn_mfma_f32_16x16x32_bf16(a, b, c, 0, 0, 0); }
DEVI float ex2(float x) { return __builtin_amdgcn_exp2f(x); }
DEVI int clampi(int v, int lo, int hi) { return v < lo ? lo : (v > hi ? hi : v); }
DEVI int cond_of_row(int t) { return t < TC ? 0 : 1 + ((t - TC) >> 11); }

DEVI void transpose_tile(const float* __restrict__ W, bf16_t* __restrict__ Wt, int K, int N, int tk, int tn, float* sm) {
    const int tid = TIDX();
#pragma unroll
    for (int p = 0; p < 2; ++p) {
        const int kr = p * 32 + (tid >> 4), nc = (tid & 15) * 4;
        const int gk = tk * 64 + kr, gn = tn * 64 + nc;
        f32x4 v = {0.f, 0.f, 0.f, 0.f};
        if (gn < N) v = *(const f32x4*)(W + (size_t)gk * N + gn);
        sm[kr * 65 + nc + 0] = v[0]; sm[kr * 65 + nc + 1] = v[1]; sm[kr * 65 + nc + 2] = v[2]; sm[kr * 65 + nc + 3] = v[3];
    }
    __syncthreads();
    const int n = tid >> 3, kg = tid & 7;
    float f[8];
#pragma unroll
    for (int j = 0; j < 8; ++j) f[j] = sm[(kg * 8 + j) * 65 + n];
    const u32x4 o = {cvt_pk_bf16(f[0], f[1]), cvt_pk_bf16(f[2], f[3]), cvt_pk_bf16(f[4], f[5]), cvt_pk_bf16(f[6], f[7])};
    *(u32x4*)(Wt + (size_t)(tn * 64 + n) * K + tk * 64 + kg * 8) = o;
    __syncthreads();
}
DEVI void conv_T(const float* W, bf16_t* Wt, int K, int N, int Npad, int nmat, int rot, float* sm) {
    const int tkn = K / 64, tnn = Npad / 64, per = tkn * tnn, total = per * nmat;
    const int start = (int)((BIDX() + gridDim.x - (rot % gridDim.x)) % gridDim.x);
    for (int t = start; t < total; t += gridDim.x) {
        const int mat = t / per, r = t % per, tk = r / tnn, tn = r % tnn;
        transpose_tile(W + (size_t)mat * K * N, Wt + (size_t)mat * Npad * K, K, N, tk, tn, sm);
    }
}
DEVI void conv_T2_unit(const float* __restrict__ W, bf16_t* __restrict__ Wt, int K, int N, int Npad, int u, int tid) {
    const int nbn = (Npad + 2047) / 2048;
    const int kb = u / nbn, nb = u % nbn;
    const int n = nb * 2048 + tid * 4;
    if (n >= Npad) return;
    f32x4 r[16];
    const float* src = W + (size_t)(kb * 16) * N + n;
#pragma unroll
    for (int j = 0; j < 16; ++j) r[j] = n < N ? __builtin_nontemporal_load((const f32x4*)(src + (size_t)j * N)) : (f32x4){0.f, 0.f, 0.f, 0.f};
#pragma unroll
    for (int i = 0; i < 4; ++i) {
        const u32x4 lo = {cvt_pk_bf16(r[0][i], r[1][i]), cvt_pk_bf16(r[2][i], r[3][i]), cvt_pk_bf16(r[4][i], r[5][i]), cvt_pk_bf16(r[6][i], r[7][i])};
        const u32x4 hi = {cvt_pk_bf16(r[8][i], r[9][i]), cvt_pk_bf16(r[10][i], r[11][i]), cvt_pk_bf16(r[12][i], r[13][i]), cvt_pk_bf16(r[14][i], r[15][i])};
        bf16_t* d = Wt + (size_t)(n + i) * K + kb * 16;
        *(u32x4*)d = lo; *(u32x4*)(d + 8) = hi;
    }
}
DEVI void conv_T3_unit(const float* __restrict__ W, bf16_t* __restrict__ Wt, int K, int N, int tn, int tk0, int ntk, int rot, float* sm, int tid) {
    const int kr = tid >> 4, nc = (tid & 15) * 4, gn = tn * 64 + nc;
    const int n = tid >> 3, kg = tid & 7;
    const bool inb = gn < N;
    f32x4 v0 = {0.f, 0.f, 0.f, 0.f}, v1 = v0;
    { const int tk = tk0 + (rot % ntk);
      if (inb) { v0 = __builtin_nontemporal_load((const f32x4*)(W + (size_t)(tk * 64 + kr) * N + gn)); v1 = __builtin_nontemporal_load((const f32x4*)(W + (size_t)(tk * 64 + 32 + kr) * N + gn)); } }
    for (int i = 0; i < ntk; ++i) {
        const int tk = tk0 + ((rot + i) % ntk);
        sm[kr * 65 + nc + 0] = v0[0]; sm[kr * 65 + nc + 1] = v0[1]; sm[kr * 65 + nc + 2] = v0[2]; sm[kr * 65 + nc + 3] = v0[3];
        sm[(32 + kr) * 65 + nc + 0] = v1[0]; sm[(32 + kr) * 65 + nc + 1] = v1[1]; sm[(32 + kr) * 65 + nc + 2] = v1[2]; sm[(32 + kr) * 65 + nc + 3] = v1[3];
        if (i + 1 < ntk && inb) {
            const int tk2 = tk0 + ((rot + i + 1) % ntk);
            v0 = __builtin_nontemporal_load((const f32x4*)(W + (size_t)(tk2 * 64 + kr) * N + gn)); v1 = __builtin_nontemporal_load((const f32x4*)(W + (size_t)(tk2 * 64 + 32 + kr) * N + gn));
        }
        __syncthreads();
        float f[8];
#pragma unroll
        for (int j = 0; j < 8; ++j) f[j] = sm[(kg * 8 + j) * 65 + n];
        const u32x4 o = {cvt_pk_bf16(f[0], f[1]), cvt_pk_bf16(f[2], f[3]), cvt_pk_bf16(f[4], f[5]), cvt_pk_bf16(f[6], f[7])};
        *(u32x4*)(Wt + (size_t)(tn * 64 + n) * K + tk * 64 + kg * 8) = o;
        __syncthreads();
    }
}
DEVI void conv_plain(const float* __restrict__ src, bf16_t* __restrict__ dst, size_t n4) {
    const size_t nthr = (size_t)gridDim.x * 512;
    for (size_t i0 = (size_t)BIDX() * 512 + TIDX(); i0 < n4; i0 += 4 * nthr) {
        f32x4 v[4];
#pragma unroll
        for (int u = 0; u < 4; ++u) { const size_t i = i0 + u * nthr; if (i < n4) v[u] = __builtin_nontemporal_load((const f32x4*)(src + i * 4)); }
#pragma unroll
        for (int u = 0; u < 4; ++u) { const size_t i = i0 + u * nthr; if (i < n4) st4(dst + i * 4, v[u]); }
    }
}
DEVI void weight_units(const P& p, int l, int u0, int u1, int w, int nw, float* sm) {
    const int tid = TIDX();
    char* ws = WSP(p.ws);
    const int rot = w & 15;
    for (int u = u0 + w; u < u1; u += nw) {
        int v = u;
        if (v < 216) conv_T3_unit(p.in[I_WIN] + (size_t)l * D * NIN, (bf16_t*)(ws + W_WIN) + (size_t)l * NINP * D, D, NIN, v >> 1, (v & 1) * 16, 16, rot, sm, tid);
        else if ((v -= 216) < 64) conv_T3_unit(p.in[I_WOUT] + (size_t)l * D * D, (bf16_t*)(ws + W_WOUT) + (size_t)l * D * D, D, D, v >> 1, (v & 1) * 16, 16, rot, sm, tid);
        else if ((v -= 64) < 344) conv_T3_unit(p.in[I_WUP] + (size_t)l * D * NUP, (bf16_t*)(ws + W_WUP) + (size_t)l * NUP * D, D, NUP, v >> 1, (v & 1) * 16, 16, rot, sm, tid);
        else { v -= 344; const int part = v % 6; conv_T3_unit(p.in[I_WDN] + (size_t)l * DFF * D, (bf16_t*)(ws + W_WDN) + (size_t)l * D * DFF, DFF, D, v / 6, part * 16, part == 5 ? 6 : 16, rot, sm, tid); }
    }
}
DEVI void phase0a(const P& p, float* sm) {
    const int tid = TIDX();
    char* ws = WSP(p.ws);
    for (int it = BIDX(); it < 768; it += gridDim.x) {
        const int l = it / 384, kc = (it % 384) / 6, jb = it % 6;
        if (tid < 96) { const int ci = tid >> 5, k = kc * 32 + (tid & 31); const float cv = ci == 0 ? p.in[I_CCTX][k] : p.in[I_C][(ci - 1) * D + k]; sm[tid] = siluf_(cv); }
        __syncthreads();
        const int j = jb * 2048 + tid * 4;
        f32x4 a0 = {0.f, 0.f, 0.f, 0.f}, a1 = a0, a2 = a0;
        const float* wp = p.in[I_WMOD] + ((size_t)l * D + kc * 32) * 12288 + j;
#pragma unroll
        for (int h2 = 0; h2 < 2; ++h2) {
            f32x4 w[16];
#pragma unroll
            for (int kk = 0; kk < 16; ++kk) w[kk] = __builtin_nontemporal_load((const f32x4*)(wp + (size_t)(h2 * 16 + kk) * 12288));
#pragma unroll
            for (int kk = 0; kk < 16; ++kk) { a0 += sm[h2 * 16 + kk] * w[kk]; a1 += sm[32 + h2 * 16 + kk] * w[kk]; a2 += sm[64 + h2 * 16 + kk] * w[kk]; }
        }
        float* mp = (float*)(ws + W_MODP2) + ((size_t)(l * 64 + kc) * 3) * 12288 + j;
        *(f32x4*)(mp) = a0; *(f32x4*)(mp + 12288) = a1; *(f32x4*)(mp + 2 * 12288) = a2;
        __syncthreads();
    }
#if PROBE
    if (blockIdx.x == 0 && threadIdx.x == 0) ((unsigned long long*)(p.ws + W_CNT + 2048))[45] = wall_clock64();
#endif
    if (BIDX() == gridDim.x - 1) {
        float* rt = (float*)(ws + W_ROPE);
        for (int i = tid; i < 1024; i += 512) {
            const int pos = i >> 4, fi = i & 15;
            const float freq = __expf(-(float)fi * 0.5756462732485115f);
            const float ang = (float)pos * freq;
            rt[i] = __cosf(ang); rt[1024 + i] = __sinf(ang);
        }
    }
    weight_units(p, 0, 0, 280, BIDX(), (int)gridDim.x, sm);
    conv_T(p.in[I_CAV], (bf16_t*)(ws + W_CVA), 512, 128, 128, 24, 100, sm);
    conv_T(p.in[I_CBV], (bf16_t*)(ws + W_CVB), 512, 128, 128, 20, 200, sm);
    conv_plain(p.in[I_CAK], (bf16_t*)(ws + W_CKA), (size_t)24 * 65536 / 4);
    conv_plain(p.in[I_CBK], (bf16_t*)(ws + W_CKB), (size_t)20 * 65536 / 4);
}
DEVI void phase0b(const P& p) {
    const float* mp = (const float*)(WSP(p.ws) + W_MODP2);
    float* mo = (float*)(WSP(p.ws) + W_MODS);
    for (int i = BIDX() * 512 + TIDX(); i < 2 * 3 * 12288; i += gridDim.x * 512) {
        const int l = i / 36864, r = i % 36864, ci = r / 12288, j = r % 12288;
        float s = p.in[I_BMOD][l * 12288 + j];
        float s2 = 0.f, s3 = 0.f, s4 = 0.f;
#pragma unroll 4
        for (int kc = 0; kc < 64; kc += 4) {
            s += mp[((size_t)(l * 64 + kc) * 3 + ci) * 12288 + j]; s2 += mp[((size_t)(l * 64 + kc + 1) * 3 + ci) * 12288 + j];
            s3 += mp[((size_t)(l * 64 + kc + 2) * 3 + ci) * 12288 + j]; s4 += mp[((size_t)(l * 64 + kc + 3) * 3 + ci) * 12288 + j];
        }
        s += s2 + s3 + s4;
        mo[i] = s;
    }
}
DEVI void phase0c(const P& p) {
    const float* __restrict__ mods = (const float*)(WSP(p.ws) + W_MODS);
    bf16_t* __restrict__ H = (bf16_t*)(WSP(p.ws) + W_H);
    const float* __restrict__ xp = p.in[I_XP]; const float* __restrict__ xs = p.in[I_XS];
    const int nthr = gridDim.x * 512;
    for (int i0 = BIDX() * 512 + TIDX(); i0 < T * 512; i0 += 4 * nthr) {
        f32x4 x[4], sh[4], sc[4];
#pragma unroll
        for (int u = 0; u < 4; ++u) {
            const int i = i0 + u * nthr;
            if (i < T * 512) {
                const int t = i >> 9, c = (i & 511) * 4;
                const float* xr = t < TC ? xp + (size_t)t * D : xs + (size_t)(t - TC) * D;
                const float* mr = mods + (size_t)cond_of_row(t) * 12288;
                x[u] = *(const f32x4*)(xr + c); sh[u] = *(const f32x4*)(mr + c); sc[u] = *(const f32x4*)(mr + 2048 + c);
            }
        }
#pragma unroll
        for (int u = 0; u < 4; ++u) {
            const int i = i0 + u * nthr;
            if (i < T * 512) { const int t = i >> 9, c = (i & 511) * 4; st4(H + (size_t)t * D + c, x[u] * (1.0f + sc[u]) + sh[u]); }
        }
    }
}

struct EpiIn {
    static constexpr bool PERM = false, AFTER_DRAIN = false;
    char* ws; float* out; const float* gate_b; int l;
    DEVI void operator()(const f32x4 (&acc)[2][2][4][2], const pg8::Unit& u, int wr, int wc, int fr, int fq) const {
        asm volatile("" : "+v"(fr), "+v"(fq), "+s"(wr), "+s"(wc));
        const bool ctx = u.pm < 16;
        const int b = ctx ? u.pm : ((u.pm - 16) >> 3);
        const int sbase = (ctx ? 0 : ((u.pm - 16) & 7) * 256) + wr * 64 + fr;
        const int rbase = u.pm * 256 + wr * 64 + fr;
        const int S = ctx ? 256 : 2048;
        const int dc = wc * 32 + fq * 4;
        const float* rope = (const float*)(ws + W_ROPE);
        const int lay = l;
        half<0>(acc, u, wr, wc, fr, fq, ctx, b, sbase, rbase, S, dc, rope, lay);
        half<1>(acc, u, wr, wc, fr, fq, ctx, b, sbase, rbase, S, dc, rope, lay);
    }
    template <int bj>
    DEVI void half(const f32x4 (&acc)[2][2][4][2], const pg8::Unit& u, int wr, int wc, int fr, int fq, bool ctx, int b, int sbase, int rbase, int S, int dc, const float* rope, int lay) const {
        {
            const int cgi = 2 * u.pn + bj;
            if (cgi >= 54) return;
            auto each = [&](auto f) __attribute__((always_inline)) {
#pragma unroll
                for (int ai = 0; ai < 2; ++ai)
#pragma unroll
                    for (int m = 0; m < 4; ++m)
#pragma unroll
                        for (int n = 0; n < 2; ++n) f(acc[ai][bj][m][n], rbase + 128 * ai + 16 * m, sbase + 128 * ai + 16 * m, n);
            };
            auto tokmaj = [&](bf16_t* base, int stride, int head, float mul) __attribute__((always_inline)) {
                each([&](f32x4 v, int r, int s, int n) __attribute__((always_inline)) { st4(base + (size_t)r * stride + head * 128 + dc + 16 * n, v * mul); });
            };
            auto transp = [&](bf16_t* base, int Hn, int head) __attribute__((always_inline)) {
                bf16_t* bb = base + (ctx ? (size_t)0 : (size_t)16 * Hn * 32768) + (size_t)(b * Hn + head) * 128 * S;
                each([&](f32x4 v, int r, int s, int n) __attribute__((always_inline)) {
                    const unsigned A = cvt_pk_bf16(v[0], v[1]), B = cvt_pk_bf16(v[2], v[3]);
                    const bool odd = (fr & 1) != 0;
                    const unsigned recv = (unsigned)__builtin_amdgcn_mov_dpp((int)(odd ? A : B), 0xB1, 0xF, 0xF, true);
                    const unsigned w0 = odd ? ((recv & 0xffffu) | (B << 16)) : ((A & 0xffffu) | (recv << 16));
                    const unsigned w1 = odd ? ((recv >> 16) | (B & 0xffff0000u)) : ((A >> 16) | (recv & 0xffff0000u));
                    const int dd = dc + 16 * n + (odd ? 2 : 0), s2 = odd ? s - 1 : s;
                    *(unsigned*)(bb + (size_t)dd * S + s2) = w0;
                    *(unsigned*)(bb + (size_t)(dd + 1) * S + s2) = w1;
                });
            };
            auto outf = [&](float* obase, int Hn, int head) __attribute__((always_inline)) {
                float* ob = obase + (size_t)((b * 2 + lay) * Hn + head) * 32768;
                each([&](f32x4 v, int r, int s, int n) __attribute__((always_inline)) { *(f32x4*)(ob + (size_t)s * 128 + dc + 16 * n) = v; });
            };
            if (cgi < 6) {
                tokmaj((bf16_t*)(ws + W_QA), 768, cgi, 1.0f);
            } else if (cgi < 12) {
                tokmaj((bf16_t*)(ws + W_KA), 768, cgi - 6, 1.0f);
                if (ctx) outf(out + O_AK, 6, cgi - 6);
            } else if (cgi < 18) {
                transp((bf16_t*)(ws + W_VAT), 6, cgi - 12);
                if (ctx) outf(out + O_AV, 6, cgi - 12);
            } else if (cgi < 28) {
                const bool isq = cgi < 23;
                const int head = isq ? cgi - 18 : cgi - 23;
                if (isq || ctx) tokmaj((bf16_t*)(ws + (isq ? W_QB : W_KB)), 640, head, 1.0f);
                if (!isq && ctx) outf(out + O_BK, 5, head);
                if (!ctx) {
                    bf16_t* rb = isq ? (bf16_t*)(ws + W_QBR) + (size_t)(rbase - TC) * 640 : (bf16_t*)(ws + W_KB) + (size_t)rbase * 640;
#pragma unroll
                    for (int ai = 0; ai < 2; ++ai)
#pragma unroll
                        for (int m = 0; m < 4; ++m) {
                            const int s = sbase + 128 * ai + 16 * m;
                            const int pos = (wc & 1) ? (s & 63) : (s >> 6);
                            const f32x4 cs = *(const f32x4*)(rope + pos * 16 + 4 * fq), sn = *(const f32x4*)(rope + 1024 + pos * 16 + 4 * fq);
                            const f32x4 x1 = acc[ai][bj][m][0], x2 = acc[ai][bj][m][1];
                            bf16_t* d = rb + (size_t)(128 * ai + 16 * m) * 640 + head * 128 + dc;
                            st4(d, x1 * cs - x2 * sn);
                            st4(d + 16, x1 * sn + x2 * cs);
                        }
                }
            } else if (cgi < 33) {
                transp((bf16_t*)(ws + W_VBT), 5, cgi - 28);
                if (ctx) outf(out + O_BV, 5, cgi - 28);
            } else if (cgi < 38) {
                tokmaj((bf16_t*)(ws + W_QC), 640, cgi - 33, 0.08838834764831845f);
            } else if (cgi < 43) {
                tokmaj((bf16_t*)(ws + W_KC), 640, cgi - 38, 1.0f);
                transp((bf16_t*)(ws + W_KCT), 5, cgi - 38);
            } else if (cgi < 48) {
                transp((bf16_t*)(ws + W_VCT), 5, cgi - 43);
            } else if (cgi < 53) {
                bf16_t* base = (bf16_t*)(ws + W_OG);
                const int head = cgi - 48;
                each([&](f32x4 v, int r, int s, int n) __attribute__((always_inline)) {
                    f32x4 o;
#pragma unroll
                    for (int i = 0; i < 4; ++i) o[i] = sigmoidf_(v[i]);
                    st4(base + (size_t)r * 640 + head * 128 + dc + 16 * n, o);
                });
            } else {
                if (wc == 0) {
                    float* G = (float*)(ws + W_G);
                    each([&](f32x4 v, int r, int s, int n) __attribute__((always_inline)) {
                        if (n == 0 || fq == 0) {
#pragma unroll
                            for (int i = 0; i < 4; ++i) {
                                const int col = 16 * n + 4 * fq + i;
                                float x = v[i] + gate_b[lay * 20 + col];
                                if ((col / 5) & 1) { const float ee = __expf(-fabsf(x)), uu = 1.0f + ee, dd = uu - 1.0f; x = fminf(x, 0.f) - (dd == 0.f ? ee : __logf(uu) * (ee / dd)); }
                                G[(size_t)r * 20 + col] = x;
                            }
                        }
                    });
                }
            }
        }
    }
};
struct EpiRes {
    static constexpr bool PERM = false, AFTER_DRAIN = false;
    const float* xin_c; const float* xin_l; float* X; const float* gate;
    DEVI void operator()(const f32x4 (&acc)[2][2][4][2], const pg8::Unit& u, int wr, int wc, int fr, int fq) const {
        asm volatile("" : "+v"(fr), "+v"(fq), "+s"(wr), "+s"(wc));
        const int row0 = u.pm * 256 + wr * 64 + fr, col0 = u.pn * 256 + wc * 32 + 4 * fq;
        const float* gr = gate + (size_t)(u.pm < 16 ? 0 : 1 + ((u.pm - 16) >> 3)) * 12288;
        f32x4 gv[2][2];
#pragma unroll
        for (int bj = 0; bj < 2; ++bj)
#pragma unroll
            for (int n = 0; n < 2; ++n) gv[bj][n] = *(const f32x4*)(gr + col0 + bj * 128 + n * 16);
#pragma unroll
        for (int ai = 0; ai < 2; ++ai)
#pragma unroll
            for (int m = 0; m < 4; ++m) {
                const int r = row0 + ai * 128 + m * 16;
                const float* xr = (r < TC ? xin_c + (size_t)r * D : xin_l + (size_t)(r - TC) * D) + col0;
                float* xo = X + (size_t)r * D + col0;
#pragma unroll
                for (int bj = 0; bj < 2; ++bj)
#pragma unroll
                    for (int n = 0; n < 2; ++n) {
                        const f32x4 xv = *(const f32x4*)(xr + bj * 128 + n * 16);
                        *(f32x4*)(xo + bj * 128 + n * 16) = ALPHA * xv + gv[bj][n] * acc[ai][bj][m][n];
                    }
            }
    }
};
struct EpiResLN {
    static constexpr bool PERM = true, AFTER_DRAIN = true;
    const float* xin_c; const float* xin_l; float* xout; const float* gate; const float* gam; const float* bet; const float* hmods; bf16_t* H; float* stats; unsigned* cnt; int xs_in, xs_out;
    DEVI void operator()(const f32x4 (&)[2][2][4][2], const pg8::Unit&, int, int, int, int) const {}
    DEVI void fused(f32x4 (&acc)[2][2][4][2], const pg8::Unit& u, int wr, int wc, int fr, int fq, PG8_LAS unsigned char* lds, int wid, int lane) const {
        asm volatile("" : "+v"(fr), "+v"(fq), "+s"(wr), "+s"(wc));
        const int tid = wid * 64 + lane;
        const int cond = u.pm < 16 ? 0 : 1 + ((u.pm - 16) >> 3);
        const int row0 = u.pm * 256 + wr * 64 + fr, col0 = u.pn * 256 + wc * 32 + 8 * fq;
        {
            const float* gr = gate + (size_t)cond * 12288 + col0;
            f32x4 gv[2][2];
#pragma unroll
            for (int bj = 0; bj < 2; ++bj)
#pragma unroll
                for (int n = 0; n < 2; ++n) gv[bj][n] = *(const f32x4*)(gr + bj * 128 + n * 4);
#pragma unroll
            for (int ai = 0; ai < 2; ++ai)
#pragma unroll
                for (int m = 0; m < 4; ++m) {
                    const int r = row0 + ai * 128 + m * 16;
                    const float* xr = (r < TC ? xin_c + (size_t)r * xs_in : xin_l + (size_t)(r - TC) * xs_in) + col0;
#pragma unroll
                    for (int bj = 0; bj < 2; ++bj)
#pragma unroll
                        for (int n = 0; n < 2; ++n) acc[ai][bj][m][n] = ALPHA * *(const f32x4*)(xr + bj * 128 + n * 4) + gv[bj][n] * acc[ai][bj][m][n];
                }
        }
        PG8_LAS float* red = (PG8_LAS float*)lds;
        PG8_LAS float* mr = (PG8_LAS float*)(lds + 32768);
#pragma unroll
        for (int ai = 0; ai < 2; ++ai)
#pragma unroll
            for (int m = 0; m < 4; ++m) {
                float sv = 0.f, qv = 0.f;
#pragma unroll
                for (int bj = 0; bj < 2; ++bj)
#pragma unroll
                    for (int n = 0; n < 2; ++n) {
                        const f32x4 z = acc[ai][bj][m][n];
                        sv += z[0] + z[1] + z[2] + z[3];
                        qv += z[0] * z[0] + z[1] * z[1] + z[2] * z[2] + z[3] * z[3];
                    }
                { const int rl = ai * 128 + wr * 64 + m * 16 + fr; red[(rl * 16 + wc * 4 + fq) * 2] = sv; red[(rl * 16 + wc * 4 + fq) * 2 + 1] = qv; }
            }
        __syncthreads();
        float* st = stats + ((size_t)u.pm * 256) * 16;
        if (tid < 256) {
            float sv = 0.f, qv = 0.f;
#pragma unroll
            for (int w = 0; w < 16; ++w) { sv += red[(tid * 16 + w) * 2]; qv += red[(tid * 16 + w) * 2 + 1]; }
            st[(tid * 8 + u.pn) * 2] = sv; st[(tid * 8 + u.pn) * 2 + 1] = qv;
        }
        asm volatile("s_waitcnt vmcnt(0)" ::: "memory");
        __syncthreads();
        if (tid == 0) {
            __hip_atomic_fetch_add(cnt + u.pm, 1u, __ATOMIC_RELEASE, __HIP_MEMORY_SCOPE_AGENT);
            while (__hip_atomic_load(cnt + u.pm, __ATOMIC_RELAXED, __HIP_MEMORY_SCOPE_AGENT) < 8u) __builtin_amdgcn_s_sleep(1);
        }
        __syncthreads();
        if (tid < 256) {
            __builtin_amdgcn_fence(__ATOMIC_ACQUIRE, "agent");
            float sv = 0.f, qv = 0.f;
#pragma unroll
            for (int w = 0; w < 8; ++w) {
                sv += __builtin_nontemporal_load(st + (tid * 8 + w) * 2); qv += __builtin_nontemporal_load(st + (tid * 8 + w) * 2 + 1);
            }
            const float mu = sv * (1.0f / D), var = fmaxf(qv * (1.0f / D) - mu * mu, 0.f);
            mr[tid * 2] = mu; mr[tid * 2 + 1] = rsqrtf(var + 1e-5f);
        }
        __syncthreads();
        {
            float mu[8], rs_[8];
#pragma unroll
            for (int ai = 0; ai < 2; ++ai)
#pragma unroll
                for (int m = 0; m < 4; ++m) { const int rl = ai * 128 + wr * 64 + m * 16 + fr; mu[ai * 4 + m] = mr[rl * 2]; rs_[ai * 4 + m] = mr[rl * 2 + 1]; }
#pragma unroll
            for (int bj = 0; bj < 2; ++bj) {
                const int c = col0 + bj * 128;
                f32x4 gmv[2], btv[2], shv[2], scv[2];
#pragma unroll
                for (int n = 0; n < 2; ++n) {
                    gmv[n] = *(const f32x4*)(gam + c + 4 * n); btv[n] = *(const f32x4*)(bet + c + 4 * n);
                    shv[n] = (f32x4){0.f, 0.f, 0.f, 0.f}; scv[n] = shv[n];
                    if (hmods) { const float* hm = hmods + (size_t)cond * 12288 + c + 4 * n; shv[n] = *(const f32x4*)hm; scv[n] = 1.0f + *(const f32x4*)(hm + 2048); }
                }
#pragma unroll
                for (int ai = 0; ai < 2; ++ai)
#pragma unroll
                    for (int m = 0; m < 4; ++m) {
                        const int r = u.pm * 256 + ai * 128 + wr * 64 + m * 16 + fr;
                        const f32x4 y0 = (acc[ai][bj][m][0] - mu[ai * 4 + m]) * rs_[ai * 4 + m] * gmv[0] + btv[0];
                        const f32x4 y1 = (acc[ai][bj][m][1] - mu[ai * 4 + m]) * rs_[ai * 4 + m] * gmv[1] + btv[1];
                        *(f32x4*)(xout + (size_t)r * xs_out + c) = y0; *(f32x4*)(xout + (size_t)r * xs_out + c + 4) = y1;
                        if (hmods) {
                            const f32x4 h0 = y0 * scv[0] + shv[0], h1 = y1 * scv[1] + shv[1];
                            const u32x4 o = {cvt_pk_bf16(h0[0], h0[1]), cvt_pk_bf16(h0[2], h0[3]), cvt_pk_bf16(h1[0], h1[1]), cvt_pk_bf16(h1[2], h1[3])};
                            *(u32x4*)(H + (size_t)r * D + c) = o;
                        }
                    }
            }
        }
    }
};
struct EpiU {
    static constexpr bool PERM = true, AFTER_DRAIN = false;
    bf16_t* U;
    DEVI void operator()(const f32x4 (&acc)[2][2][4][2], const pg8::Unit& u, int wr, int wc, int fr, int fq) const {
        asm volatile("" : "+v"(fr), "+v"(fq), "+s"(wr), "+s"(wc));
        const int row0 = u.pm * 256 + wr * 64 + fr, col0 = u.pn * 256 + wc * 32 + 8 * fq;
#pragma unroll
        for (int ai = 0; ai < 2; ++ai)
#pragma unroll
            for (int m = 0; m < 4; ++m) {
                bf16_t* ur = U + (size_t)(row0 + ai * 128 + m * 16) * NUP + col0;
#pragma unroll
                for (int bj = 0; bj < 2; ++bj) {
                    const f32x4 v0 = acc[ai][bj][m][0], v1 = acc[ai][bj][m][1];
                    const u32x4 o = {cvt_pk_bf16(v0[0], v0[1]), cvt_pk_bf16(v0[2], v0[3]), cvt_pk_bf16(v1[0], v1[1]), cvt_pk_bf16(v1[2], v1[3])};
                    *(u32x4*)(ur + bj * 128) = o;
                }
            }
    }
};

DEVI void ln_phase(const P& p, int l, int which) {
    const int lane = TIDX() & 63, wid = TIDX() >> 6;
    float* X = (float*)(WSP(p.ws) + W_X);
    const float* gam = p.in[which ? I_LN2G : I_LN1G] + l * D;
    const float* bet = p.in[which ? I_LN2B : I_LN1B] + l * D;
    const bool last = which == 1 && l == 1;
    const float* mods = (const float*)(WSP(p.ws) + W_MODS) + (size_t)(which ? l + 1 : l) * 36864 + (which ? 0 : 3 * 2048);
    bf16_t* H = (bf16_t*)(WSP(p.ws) + W_H);
    f32x4 gv[8], bv[8];
#pragma unroll
    for (int j = 0; j < 8; ++j) { gv[j] = *(const f32x4*)(gam + 4 * lane + 256 * j); bv[j] = *(const f32x4*)(bet + 4 * lane + 256 * j); }
    const int wstride = gridDim.x * 8;
    for (int t0 = BIDX() * 8 + wid; t0 < T; t0 += 2 * wstride) {
        const int t1 = t0 + wstride;
        const bool has1 = t1 < T;
        f32x4 v0[8], v1[8];
        float s0 = 0.f, s1 = 0.f;
#pragma unroll
        for (int j = 0; j < 8; ++j) v0[j] = *(const f32x4*)(X + (size_t)t0 * D + 4 * lane + 256 * j);
#pragma unroll
        for (int j = 0; j < 8; ++j) v1[j] = has1 ? *(const f32x4*)(X + (size_t)t1 * D + 4 * lane + 256 * j) : (f32x4){0.f, 0.f, 0.f, 0.f};
#pragma unroll
        for (int j = 0; j < 8; ++j) { s0 += v0[j][0] + v0[j][1] + v0[j][2] + v0[j][3]; s1 += v1[j][0] + v1[j][1] + v1[j][2] + v1[j][3]; }
#pragma unroll
        for (int o = 32; o > 0; o >>= 1) { s0 += __shfl_xor(s0, o); s1 += __shfl_xor(s1, o); }
        const float mu0 = s0 * (1.0f / D), mu1 = s1 * (1.0f / D);
        float q0 = 0.f, q1 = 0.f;
#pragma unroll
        for (int j = 0; j < 8; ++j) {
            v0[j] -= mu0; v1[j] -= mu1;
            q0 += v0[j][0] * v0[j][0] + v0[j][1] * v0[j][1] + v0[j][2] * v0[j][2] + v0[j][3] * v0[j][3];
            q1 += v1[j][0] * v1[j][0] + v1[j][1] * v1[j][1] + v1[j][2] * v1[j][2] + v1[j][3] * v1[j][3];
        }
#pragma unroll
        for (int o = 32; o > 0; o >>= 1) { q0 += __shfl_xor(q0, o); q1 += __shfl_xor(q1, o); }
        const float r0 = rsqrtf(q0 * (1.0f / D) + 1e-5f), r1 = rsqrtf(q1 * (1.0f / D) + 1e-5f);
#pragma unroll
        for (int rr = 0; rr < 2; ++rr) {
            if (rr == 1 && !has1) break;
            const int t = rr ? t1 : t0;
            const float rstd = rr ? r1 : r0;
            float* dst = last ? p.out + O_Y + (size_t)t * D : X + (size_t)t * D;
            const float* mr = mods + (size_t)cond_of_row(t) * 12288;
#pragma unroll
            for (int j = 0; j < 8; ++j) {
                const int c = 4 * lane + 256 * j;
                const f32x4 y = (rr ? v1[j] : v0[j]) * rstd * gv[j] + bv[j];
                *(f32x4*)(dst + c) = y;
                if (!last) st4(H + (size_t)t * D + c, y * (1.0f + *(const f32x4*)(mr + 2048 + c)) + *(const f32x4*)(mr + c));
            }
        }
    }
}

DEVI void conv_phase(const P& p, int l) {
    const bf16_t* U = (const bf16_t*)(WSP(p.ws) + W_U);
    bf16_t* A = (bf16_t*)(WSP(p.ws) + W_ACT);
    const float* cw = p.in[I_CONVW] + (size_t)l * 3 * NUP;
    const float* cb = p.in[I_CONVB] + (size_t)l * NUP;
    for (int id = BIDX() * 512 + TIDX(); id < 512 * 688; id += gridDim.x * 512) {
        const int trun = id / 688, cgp = id % 688, j0 = cgp * 8, t0 = trun * 16;
        const int S = t0 < TC ? 256 : 2048;
        const int s0 = t0 < TC ? (t0 & 255) : ((t0 - TC) & 2047);
        float wa[3][8], wg[3][8], ba[8], bg[8];
#pragma unroll
        for (int k = 0; k < 3; ++k)
#pragma unroll
            for (int h = 0; h < 2; ++h) {
                const f32x4 x = *(const f32x4*)(cw + (size_t)k * NUP + j0 + 4 * h), y = *(const f32x4*)(cw + (size_t)k * NUP + DFF + j0 + 4 * h);
#pragma unroll
                for (int i = 0; i < 4; ++i) { wa[k][4 * h + i] = x[i]; wg[k][4 * h + i] = y[i]; }
            }
#pragma unroll
        for (int h = 0; h < 2; ++h) {
            const f32x4 x = *(const f32x4*)(cb + j0 + 4 * h), y = *(const f32x4*)(cb + DFF + j0 + 4 * h);
#pragma unroll
            for (int i = 0; i < 4; ++i) { ba[4 * h + i] = x[i]; bg[4 * h + i] = y[i]; }
        }
        const u32x4 zero = {0u, 0u, 0u, 0u};
        auto lda = [&](int t) { return *(const u32x4*)(U + (size_t)t * NUP + j0); };
        auto ldg = [&](int t) { return *(const u32x4*)(U + (size_t)t * NUP + DFF + j0); };
        u32x4 pa = s0 > 0 ? lda(t0 - 1) : zero, pg = s0 > 0 ? ldg(t0 - 1) : zero;
        u32x4 ca = lda(t0), cgv = ldg(t0);
        auto outrow = [&](int t, const u32x4& xa, const u32x4& ya, const u32x4& za, const u32x4& xg, const u32x4& yg, const u32x4& zg) {
            float o[8];
#pragma unroll
            for (int w = 0; w < 4; ++w) {
                const float a0 = wa[0][2 * w] * bflo(xa[w]) + wa[1][2 * w] * bflo(ya[w]) + wa[2][2 * w] * bflo(za[w]) + ba[2 * w];
                const float a1 = wa[0][2 * w + 1] * bfhi(xa[w]) + wa[1][2 * w + 1] * bfhi(ya[w]) + wa[2][2 * w + 1] * bfhi(za[w]) + ba[2 * w + 1];
                const float g0 = wg[0][2 * w] * bflo(xg[w]) + wg[1][2 * w] * bflo(yg[w]) + wg[2][2 * w] * bflo(zg[w]) + bg[2 * w];
                const float g1 = wg[0][2 * w + 1] * bfhi(xg[w]) + wg[1][2 * w + 1] * bfhi(yg[w]) + wg[2][2 * w + 1] * bfhi(zg[w]) + bg[2 * w + 1];
                o[2 * w] = siluf_(g0) * a0; o[2 * w + 1] = siluf_(g1) * a1;
            }
            const u32x4 ov = {cvt_pk_bf16(o[0], o[1]), cvt_pk_bf16(o[2], o[3]), cvt_pk_bf16(o[4], o[5]), cvt_pk_bf16(o[6], o[7])};
            *(u32x4*)(A + (size_t)t * DFF + j0) = ov;
        };
        for (int i = 0; i < 16; i += 4) {
            const int t = t0 + i;
            u32x4 na[4], ng[4];
#pragma unroll
            for (int k = 0; k < 4; ++k) {
                const bool hn = (s0 + i + k + 1) < S;
                na[k] = hn ? lda(t + k + 1) : zero; ng[k] = hn ? ldg(t + k + 1) : zero;
            }
            outrow(t, pa, ca, na[0], pg, cgv, ng[0]);
            outrow(t + 1, ca, na[0], na[1], cgv, ng[0], ng[1]);
            outrow(t + 2, na[0], na[1], na[2], ng[0], ng[1], ng[2]);
            outrow(t + 3, na[1], na[2], na[3], ng[1], ng[2], ng[3]);
            pa = na[2]; pg = ng[2]; ca = na[3]; cgv = ng[3];
        }
    }
}

constexpr size_t LATV_A = (size_t)16 * 6 * 32768, LATV_B = (size_t)16 * 5 * 32768;
template <bool DIFF>
DEVI void attn_item(const bf16_t* qrow0, const bf16_t* qrow1,
                    const bf16_t* K0, int ks0, int kstart0, int tstep0, int nt0, const bf16_t* VT0, int vs0,
                    const bf16_t* K1, int ks1, int nt1, const bf16_t* VT1, int vs1,
                    bool neigh, int qr, int qc0, int c0, int rs, const float* rpb_h,
                    float sc2, bf16_t* yrow, float lam, const float* subln, float outscale) {
    constexpr int NMAP = DIFF ? 2 : 1, NKK = DIFF ? 2 : 4;
    const int lane = TIDX() & 63, l16 = lane & 15, g = lane >> 4;
    float mrun[NMAP], lrun[NMAP];
    f32x4 o[NMAP][8];
#pragma unroll
    for (int mp = 0; mp < NMAP; ++mp) {
        mrun[mp] = -1e30f; lrun[mp] = 0.f;
#pragma unroll
        for (int dt = 0; dt < 8; ++dt) o[mp][dt] = (f32x4){0.f, 0.f, 0.f, 0.f};
    }
    bf16x8 qf[NMAP][NKK];
#pragma unroll
    for (int mp = 0; mp < NMAP; ++mp)
#pragma unroll
        for (int kk = 0; kk < NKK; ++kk) qf[mp][kk] = ld8(qrow0 + (mp * NKK + kk) * 32 + 8 * g);
    const int qc = qc0 + l16, cs = clampi(qc - 8, 0, 48);
    const int ntot = nt0 + nt1;
    for (int j = 0; j < ntot; ++j) {
        const bool s0 = j < nt0;
        if (j == nt0 && qrow1 != qrow0) {
#pragma unroll
            for (int mp = 0; mp < NMAP; ++mp)
#pragma unroll
                for (int kk = 0; kk < NKK; ++kk) qf[mp][kk] = ld8(qrow1 + (mp * NKK + kk) * 32 + 8 * g);
        }
        const int key0 = s0 ? kstart0 + j * tstep0 : (j - nt0) * 32;
        const int ks = s0 ? ks0 : ks1, vs = s0 ? vs0 : vs1;
        const bf16_t* Kt = (s0 ? K0 : K1) + (size_t)key0 * ks + (size_t)l16 * ks + 8 * g;
        const bf16_t* Vt = (s0 ? VT0 : VT1) + key0 + (size_t)l16 * vs + 4 * g;
        f32x4 s[NMAP][2];
#pragma unroll
        for (int mp = 0; mp < NMAP; ++mp)
#pragma unroll
            for (int half = 0; half < 2; ++half) {
                f32x4 a = {0.f, 0.f, 0.f, 0.f};
#pragma unroll
                for (int kk = 0; kk < NKK; ++kk) a = mfma16(ld8(Kt + (size_t)(16 * half) * ks + (mp * NKK + kk) * 32), qf[mp][kk], a);
                s[mp][half] = a;
            }
        bf16x8 vf[8];
#pragma unroll
        for (int dt = 0; dt < 8; ++dt) vf[dt] = ld4x2(Vt + (size_t)(16 * dt) * vs, Vt + (size_t)(16 * dt) * vs + 16);
#pragma unroll
        for (int mp = 0; mp < NMAP; ++mp) {
            float v[8];
#pragma unroll
            for (int half = 0; half < 2; ++half)
#pragma unroll
                for (int i = 0; i < 4; ++i) v[half * 4 + i] = s[mp][half][i] * sc2;
            if (neigh && s0) {
                const float* brow = rpb_h + (7 + rs + j - qr) * 31;
#pragma unroll
                for (int half = 0; half < 2; ++half)
#pragma unroll
                    for (int i = 0; i < 4; ++i) {
                        const int kc = c0 + 16 * half + 4 * g + i;
                        const bool ok = kc >= cs && kc < cs + 16;
                        const float bv = brow[clampi(kc - qc + 15, 0, 30)] * LOG2E;
                        v[half * 4 + i] = ok ? v[half * 4 + i] + bv : -1e30f;
                    }
            }
            float tm = fmaxf(fmaxf(fmaxf(v[0], v[1]), fmaxf(v[2], v[3])), fmaxf(fmaxf(v[4], v[5]), fmaxf(v[6], v[7])));
            tm = fmaxf(tm, __shfl_xor(tm, 16)); tm = fmaxf(tm, __shfl_xor(tm, 32));
            const float mnew = fmaxf(mrun[mp], tm), alpha = ex2(mrun[mp] - mnew);
            mrun[mp] = mnew;
            f32x4 p0, p1; float ps = 0.f;
#pragma unroll
            for (int i = 0; i < 4; ++i) { p0[i] = ex2(v[i] - mnew); p1[i] = ex2(v[4 + i] - mnew); ps += p0[i] + p1[i]; }
            lrun[mp] = lrun[mp] * alpha + ps;
            const bf16x8 pb = pack8(p0, p1);
#pragma unroll
            for (int dt = 0; dt < 8; ++dt) o[mp][dt] = mfma16(vf[dt], pb, o[mp][dt] * alpha);
        }
    }
    float inv[NMAP];
#pragma unroll
    for (int mp = 0; mp < NMAP; ++mp) { float lsum = lrun[mp]; lsum += __shfl_xor(lsum, 16); lsum += __shfl_xor(lsum, 32); inv[mp] = 1.0f / lsum; }
    if constexpr (!DIFF) {
#pragma unroll
        for (int dt = 0; dt < 8; ++dt) st4(yrow + 16 * dt + 4 * g, o[0][dt] * inv[0]);
    } else {
        float ss = 0.f;
        f32x4 ov[8];
#pragma unroll
        for (int dt = 0; dt < 8; ++dt) {
            ov[dt] = o[0][dt] * inv[0] - (lam * inv[1]) * o[1][dt];
            ss += ov[dt][0] * ov[dt][0] + ov[dt][1] * ov[dt][1] + ov[dt][2] * ov[dt][2] + ov[dt][3] * ov[dt][3];
        }
        ss += __shfl_xor(ss, 16); ss += __shfl_xor(ss, 32);
        const float rinv = rsqrtf(ss * (1.0f / 128.0f) + 1e-6f) * outscale;
#pragma unroll
        for (int dt = 0; dt < 8; ++dt) st4(yrow + 16 * dt + 4 * g, ov[dt] * rinv * *(const f32x4*)(subln + 16 * dt + 4 * g));
    }
}

DEVI float incl_scan_sum(float v, int lane) {
#pragma unroll
    for (int o = 1; o < 64; o <<= 1) { const float t = __shfl_up(v, o); if (lane >= o) v += t; }
    return v;
}
DEVI float incl_scan_max(float v, int lane) {
#pragma unroll
    for (int o = 1; o < 64; o <<= 1) { const float t = __shfl_up(v, o); if (lane >= o) v = fmaxf(v, t); }
    return v;
}
DEVI bf16x8 ones_row(int l16) { const short v = (short)(l16 == 0 ? 0x3F80 : 0); return (bf16x8){v, v, v, v, v, v, v, v}; }
DEVI bf16x8 ldf8(const float* p) { return pack8(*(const f32x4*)p, *(const f32x4*)(p + 4)); }

DEVI void m1_item(const P& p, int slot) {
    const int lane = TIDX() & 63, l16 = lane & 15, g = lane >> 4;
    int chunk, dir, bh, tok0, vs; size_t tb;
    if (slot < 640) { chunk = slot & 3; dir = (slot >> 2) & 1; bh = slot >> 3; tok0 = (bh / 5) * 256 + chunk * 64; vs = 256; tb = (size_t)bh * 128 * 256 + chunk * 64; }
    else { const int q = slot - 640; chunk = q & 31; dir = (q >> 5) & 1; bh = q >> 6; tok0 = TC + (bh / 5) * 2048 + chunk * 64; vs = 2048; tb = LATV_B + (size_t)bh * 128 * 2048 + chunk * 64; }
    const int h = bh % 5;
    char* ws = WSP(p.ws);
    const float* G = (const float*)(ws + W_G) + (size_t)(tok0 + lane) * 20;
    const float f = G[(dir ? 15 : 5) + h], ig = G[(dir ? 10 : 0) + h];
    const bf16_t* vct = (const bf16_t*)(ws + W_VCT) + tb + (size_t)l16 * vs + 8 * g;
    bf16x8 vf[8][2];
#pragma unroll
    for (int et = 0; et < 8; ++et)
#pragma unroll
        for (int ks = 0; ks < 2; ++ks) vf[et][ks] = ld8(vct + (size_t)(16 * et) * vs + 32 * ks);
    const float ps = incl_scan_sum(f, lane), total = __shfl(ps, 63);
    const float gs = (dir ? ps - f : total - ps) + ig;
    const float mloc = wave_max(gs), w = __expf(gs - mloc);
    float wv[2][8];
#pragma unroll
    for (int ks = 0; ks < 2; ++ks)
#pragma unroll
        for (int j = 0; j < 8; ++j) wv[ks][j] = __shfl(w, 32 * ks + 8 * g + j);
    const bf16x8 on = ones_row(l16);
    const bf16_t* kct0 = (const bf16_t*)(ws + W_KCT) + tb + (size_t)l16 * vs + 8 * g;
    float* ST0 = (float*)(ws + W_ST) + (size_t)slot * 16384 + l16;
    float* SN0 = (float*)(ws + W_SN) + (size_t)slot * 128 + l16;
#pragma unroll 1
    for (int dt = 0; dt < 8; ++dt) {
        const bf16_t* kct = kct0 + (size_t)(16 * dt) * vs;
        bf16x8 bk[2];
#pragma unroll
        for (int ks = 0; ks < 2; ++ks) {
            const u32x4 raw = *(const u32x4*)(kct + 32 * ks);
            const u32x4 r = {cvt_pk_bf16(bflo(raw[0]) * wv[ks][0], bfhi(raw[0]) * wv[ks][1]), cvt_pk_bf16(bflo(raw[1]) * wv[ks][2], bfhi(raw[1]) * wv[ks][3]),
                             cvt_pk_bf16(bflo(raw[2]) * wv[ks][4], bfhi(raw[2]) * wv[ks][5]), cvt_pk_bf16(bflo(raw[3]) * wv[ks][6], bfhi(raw[3]) * wv[ks][7])};
            bk[ks] = __builtin_bit_cast(bf16x8, r);
        }
        float* ST = ST0 + 16 * dt;
#pragma unroll
        for (int et = 0; et < 8; ++et) {
            f32x4 a = {0.f, 0.f, 0.f, 0.f};
#pragma unroll
            for (int ks = 0; ks < 2; ++ks) a = mfma16(vf[et][ks], bk[ks], a);
#pragma unroll
            for (int i = 0; i < 4; ++i) ST[(16 * et + 4 * g + i) * 128] = a[i];
        }
        f32x4 a = {0.f, 0.f, 0.f, 0.f};
#pragma unroll
        for (int ks = 0; ks < 2; ++ks) a = mfma16(on, bk[ks], a);
        if (g == 0) SN0[16 * dt] = a[0];
    }
    if (lane == 0) { float* SS = (float*)(ws + W_SS); SS[slot] = total; SS[1920 + slot] = mloc; }
}

template <int NC>
DEVI void m2_chain(float* base, size_t sstride, bf16_t* sb, float* SS, int slot0, int dir, bool act, bool wr_m, f32x4& C, float& m) {
    f32x4 kv[NC]; float bl[NC], ml[NC];
#pragma unroll
    for (int u = 0; u < NC; ++u) {
        const int slot = slot0 + (dir ? NC - 1 - u : u);
        kv[u] = act ? *(const f32x4*)(base + (size_t)slot * sstride) : (f32x4){0.f, 0.f, 0.f, 0.f};
        bl[u] = SS[slot]; ml[u] = SS[1920 + slot];
    }
#pragma unroll
    for (int u = 0; u < NC; ++u) {
        const int slot = slot0 + (dir ? NC - 1 - u : u);
        const float mnew = fmaxf(bl[u] + m, ml[u]), wold = __expf(bl[u] + m - mnew), wnew = __expf(ml[u] - mnew);
        if (act) { if (sb) st4(sb + (size_t)slot * 16384, C); else *(f32x4*)(base + (size_t)slot * sstride) = C; }
        if (wr_m) SS[2 * 1920 + slot] = m;
        C = wold * C + wnew * kv[u];
        m = mnew;
    }
}
DEVI void m2_phase(const P& p, int l) {
    const int tid = TIDX();
    char* ws = WSP(p.ws);
    float* SS = (float*)(ws + W_SS);
    for (int it = BIDX(); it < 180 * 9; it += gridDim.x) {
        const int sd = it / 9, slice = it % 9;
        const bool lat = sd < 20;
        const int q = lat ? sd : sd - 20, dir = q & 1, bh = q >> 1, b = bh / 5, h = bh % 5;
        const int slot0 = lat ? 640 + (bh * 2 + dir) * 32 : (bh * 2 + dir) * 4;
        const size_t sidx = (size_t)((b * 2 + l) * 2 + dir) * 5 + h;
        float m = lat ? p.in[I_SM][sidx] : 0.f;
        const bool act = slice < 8 || tid < 32;
        const int eo = slice < 8 ? slice * 2048 + tid * 4 : 0;
        const int e = eo >> 7, d0 = slice < 8 ? (eo & 127) : tid * 4;
        f32x4 C = {0.f, 0.f, 0.f, 0.f};
        if (lat && act) {
            if (slice < 8) { const float* ci = p.in[I_SC] + sidx * 16384;
#pragma unroll
                for (int i = 0; i < 4; ++i) C[i] = ci[(d0 + i) * 128 + e]; }
            else C = *(const f32x4*)(p.in[I_SN] + sidx * 128 + d0);
        }
        float* base = slice < 8 ? (float*)(ws + W_ST) + eo : (float*)(ws + W_SN) + d0;
        const size_t sstride = slice < 8 ? 16384 : 128;
        const bool wr_m = slice == 0 && tid == 0;
        bf16_t* sb = slice < 8 ? (bf16_t*)(ws + W_ACT) + eo : nullptr;
        if (lat) m2_chain<32>(base, sstride, sb, SS, slot0, dir, act, wr_m, C, m);
        else m2_chain<4>(base, sstride, sb, SS, slot0, dir, act, wr_m, C, m);
        if (!lat && act) {
            if (slice < 8) { float* co = p.out + O_CC + sidx * 16384;
#pragma unroll
                for (int i = 0; i < 4; ++i) co[(d0 + i) * 128 + e] = C[i]; }
            else *(f32x4*)(p.out + O_CN + sidx * 128 + d0) = C;
            if (slice == 0 && tid == 0) p.out[O_CM + sidx] = m;
        }
    }
}

DEVI void m3_item(const P& p, int l, int idx) {
    const int lane = TIDX() & 63, l16 = lane & 15, g = lane >> 4;
    const int tt = idx & 3, cidx = idx >> 2;
    int bh, chunk, tok0, vs, slotf, slotb; size_t tb;
    if (cidx < 320) { bh = cidx >> 2; chunk = cidx & 3; tok0 = (bh / 5) * 256 + chunk * 64; vs = 256; tb = (size_t)bh * 128 * 256 + chunk * 64; slotf = (bh * 2) * 4 + chunk; slotb = (bh * 2 + 1) * 4 + chunk; }
    else { const int q = cidx - 320; bh = q >> 5; chunk = q & 31; tok0 = TC + (bh / 5) * 2048 + chunk * 64; vs = 2048; tb = LATV_B + (size_t)bh * 128 * 2048 + chunk * 64; slotf = 640 + (bh * 2) * 32 + chunk; slotb = 640 + (bh * 2 + 1) * 32 + chunk; }
    const int h = bh % 5, tq = 16 * tt + l16;
    const bf16_t* qrow = (const bf16_t*)(WSP(p.ws) + W_QC) + (size_t)(tok0 + tq) * 640 + h * 128 + 8 * g;
    bf16x8 qf[4];
#pragma unroll
    for (int kk = 0; kk < 4; ++kk) qf[kk] = ld8(qrow + 32 * kk);
    f32x4 sT[4];
    {
        const bf16_t* kb = (const bf16_t*)(WSP(p.ws) + W_KC) + (size_t)(tok0 + l16) * 640 + h * 128 + 8 * g;
#pragma unroll
        for (int st = 0; st < 4; ++st) {
            f32x4 a = {0.f, 0.f, 0.f, 0.f};
#pragma unroll
            for (int kk = 0; kk < 4; ++kk) a = mfma16(ld8(kb + (size_t)(16 * st) * 640 + 32 * kk), qf[kk], a);
            sT[st] = a;
        }
    }
    f32x4 hsum[8];
#pragma unroll
    for (int et = 0; et < 8; ++et) hsum[et] = (f32x4){0.f, 0.f, 0.f, 0.f};
    const float* Gp = (const float*)(WSP(p.ws) + W_G) + (size_t)(tok0 + lane) * 20;
    const float* SS = (const float*)(WSP(p.ws) + W_SS);
    const bf16_t* vtb = (const bf16_t*)(WSP(p.ws) + W_VCT) + tb + (size_t)l16 * vs + 4 * g;
    for (int dir = 0; dir < 2; ++dir) {
        const int slot = dir ? slotb : slotf;
        float f = Gp[(dir ? 15 : 5) + h], ig = Gp[(dir ? 10 : 0) + h];
        if (dir) { f = __shfl(f, 63 - lane); ig = __shfl(ig, 63 - lane); }
        const float bs = incl_scan_sum(f, lane);
        float a_ = ig - bs;
        const float pm = incl_scan_max(a_, lane);
        const float mst = SS[2 * 1920 + slot];
        const float mrow = bs + fmaxf(pm, mst);
        float c_ = bs - mrow, wst = __expf(bs + mst - mrow), emr = __expf(-mrow);
        if (dir) { a_ = __shfl(a_, 63 - lane); c_ = __shfl(c_, 63 - lane); wst = __shfl(wst, 63 - lane); emr = __shfl(emr, 63 - lane); }
        const float cq = __shfl(c_, tq), wq = __shfl(wst, tq), eq = __shfl(emr, tq);
        f32x4 o[9];
        const bf16_t* Cs = (const bf16_t*)(WSP(p.ws) + W_ACT) + (size_t)slot * 16384 + (size_t)l16 * 128 + 8 * g;
#pragma unroll
        for (int et = 0; et < 8; ++et) {
            f32x4 a = {0.f, 0.f, 0.f, 0.f};
#pragma unroll
            for (int kk = 0; kk < 4; ++kk) a = mfma16(ld8(Cs + (size_t)(16 * et) * 128 + 32 * kk), qf[kk], a);
            o[et] = a * wq;
        }
        {
            const float* ns = (const float*)(WSP(p.ws) + W_SN) + (size_t)slot * 128 + 8 * g;
            f32x4 a = {0.f, 0.f, 0.f, 0.f};
#pragma unroll
            for (int kk = 0; kk < 4; ++kk) {
                bf16x8 nf = ldf8(ns + 32 * kk);
                if (l16 != 0) nf = (bf16x8){0, 0, 0, 0, 0, 0, 0, 0};
                a = mfma16(nf, qf[kk], a);
            }
            o[8] = a * wq;
        }
        const bf16x8 on = ones_row(l16);
#pragma unroll
        for (int ks = 0; ks < 2; ++ks) {
            f32x4 pp[2];
#pragma unroll
            for (int half = 0; half < 2; ++half) {
                const int st = 2 * ks + half;
#pragma unroll
                for (int i = 0; i < 4; ++i) {
                    const int s = 16 * st + 4 * g + i;
                    const float as = __shfl(a_, s);
                    const bool ok = dir ? (s >= tq) : (s <= tq);
                    pp[half][i] = ok ? sT[st][i] * __expf(as + cq) : 0.f;
                }
            }
            const bf16x8 pb = pack8(pp[0], pp[1]);
#pragma unroll
            for (int et = 0; et < 8; ++et) o[et] = mfma16(ld4x2(vtb + (size_t)(16 * et) * vs + 32 * ks, vtb + (size_t)(16 * et) * vs + 32 * ks + 16), pb, o[et]);
            o[8] = mfma16(on, pb, o[8]);
        }
        const float den = __shfl(o[8][0], l16);
        const float dinv = 1.0f / fmaxf(fabsf(den), eq);
#pragma unroll
        for (int et = 0; et < 8; ++et) hsum[et] += o[et] * dinv;
    }
    float ss = 0.f;
#pragma unroll
    for (int et = 0; et < 8; ++et) ss += hsum[et][0] * hsum[et][0] + hsum[et][1] * hsum[et][1] + hsum[et][2] * hsum[et][2] + hsum[et][3] * hsum[et][3];
    ss += __shfl_xor(ss, 16); ss += __shfl_xor(ss, 32);
    const float rinv = rsqrtf(ss * (1.0f / 128.0f) + 1e-6f);
    const bf16_t* og = (const bf16_t*)(WSP(p.ws) + W_OG) + (size_t)(tok0 + tq) * 640 + h * 128 + 4 * g;
    const float* cn = p.in[I_CNORM] + l * 128 + 4 * g;
    bf16_t* y = (bf16_t*)(WSP(p.ws) + W_Y) + (size_t)(tok0 + tq) * D + 1408 + h * 128 + 4 * g;
#pragma unroll
    for (int et = 0; et < 8; ++et) {
        const u32x2 ou = *(const u32x2*)(og + 16 * et);
        const f32x4 ogf = {bflo(ou[0]), bfhi(ou[0]), bflo(ou[1]), bfhi(ou[1])};
        st4(y + 16 * et, hsum[et] * rinv * *(const f32x4*)(cn + 16 * et) * ogf);
    }
}

#ifndef ABUF
#define ABUF 0
#endif
constexpr int KROW = 136, VROW = 72;
constexpr int KT_EL = 64 * KROW, VT_EL = 128 * VROW;
constexpr int ATT_LDS_BYTES = (2 * KT_EL + 2 * VT_EL) * 2;
typedef PG8_LAS const bf16x8* lds_b8p;
typedef PG8_LAS const u32x2* lds_u2p;
template <int N> struct IC { static constexpr int value = N; };
template <bool DIFF, bool NEIGH>
DEVI void attn_block(PG8_LAS unsigned char* lds, const bf16_t* qrow0, const bf16_t* qrow1,
                     const bf16_t* K0, int ks0, int kstart0, int nt0, const bf16_t* VT0, int vs0,
                     const bf16_t* K1, int ks1, int nt1, const bf16_t* VT1, int vs1,
                     int qr, int qc0, int c0, int rs, int rsmin, const float* rpb_h,
                     float sc2, bf16_t* yrow, float lam, const float* subln, float outscale) {
    constexpr int NMAP = DIFF ? 2 : 1, NKK = DIFF ? 2 : 4;
    const int tid = TIDX(), lane = tid & 63, l16 = lane & 15, g = lane >> 4;
    float mrun[NMAP], lrun[NMAP];
    f32x4 o[NMAP][8];
#pragma unroll
    for (int mp = 0; mp < NMAP; ++mp) {
        mrun[mp] = -1e30f; lrun[mp] = 0.f;
#pragma unroll
        for (int dt = 0; dt < 8; ++dt) o[mp][dt] = (f32x4){0.f, 0.f, 0.f, 0.f};
    }
    bf16x8 qf[NMAP][NKK];
#pragma unroll
    for (int mp = 0; mp < NMAP; ++mp)
#pragma unroll
        for (int kk = 0; kk < NKK; ++kk) qf[mp][kk] = ld8(qrow0 + (mp * NKK + kk) * 32 + 8 * g);
    const int qc = qc0 + l16, cs = clampi(qc - 8, 0, 48);
    const int ntot = nt0 + nt1;
    u32x4 kreg[2], vreg[2];
    auto gload = [&](int t) {
        const bool s0 = t < nt0;
        const int key0 = s0 ? kstart0 + 64 * t : 64 * (t - nt0);
        const bf16_t* Kb = s0 ? K0 : K1; const bf16_t* Vb = s0 ? VT0 : VT1;
        const int ks = s0 ? ks0 : ks1, vs = s0 ? vs0 : vs1;
#pragma unroll
        for (int i = 0; i < 2; ++i) {
            const int c = tid + 512 * i;
            kreg[i] = *(const __attribute__((address_space(1))) u32x4*)(Kb + (size_t)(key0 + (c >> 4)) * ks + (c & 15) * 8);
            vreg[i] = *(const __attribute__((address_space(1))) u32x4*)(Vb + (size_t)(c >> 3) * vs + key0 + (c & 7) * 8);
        }
    };
    auto lstore = [&]() {
#pragma unroll
        for (int i = 0; i < 2; ++i) {
            const int c = tid + 512 * i;
            *(PG8_LAS u32x4*)(lds + ((c >> 4) * KROW + (c & 15) * 8) * 2) = kreg[i];
            *(PG8_LAS u32x4*)(lds + (2 * KT_EL + (c >> 3) * VROW + (c & 7) * 8) * 2) = vreg[i];
        }
    };
    PG8_LAS unsigned char* Kt = lds;
    PG8_LAS unsigned char* Vt = lds + (2 * KT_EL) * 2;
    auto step = [&](auto nsc, int kofs, bool win, int kr) {
        constexpr int NS = decltype(nsc)::value;
        f32x4 s[NMAP][NS][2];
#pragma unroll
        for (int sub = 0; sub < NS; ++sub)
#pragma unroll
            for (int mp = 0; mp < NMAP; ++mp)
#pragma unroll
                for (int half = 0; half < 2; ++half) {
                    f32x4 a = {0.f, 0.f, 0.f, 0.f};
#pragma unroll
                    for (int kk = 0; kk < NKK; ++kk) a = mfma16(*(lds_b8p)(Kt + ((kofs + 32 * sub + 16 * half + l16) * KROW + (mp * NKK + kk) * 32 + 8 * g) * 2), qf[mp][kk], a);
                    s[mp][sub][half] = a;
                }
        bf16x8 pb[NMAP][NS]; float alpha[NMAP];
#pragma unroll
        for (int mp = 0; mp < NMAP; ++mp) {
            float v[NS * 8];
#pragma unroll
            for (int sub = 0; sub < NS; ++sub)
#pragma unroll
                for (int half = 0; half < 2; ++half)
#pragma unroll
                    for (int i = 0; i < 4; ++i) v[sub * 8 + half * 4 + i] = s[mp][sub][half][i] * sc2;
            if (NEIGH && win) {
                const float* brow = rpb_h + (7 + kr - qr) * 31;
#pragma unroll
                for (int half = 0; half < 2; ++half)
#pragma unroll
                    for (int i = 0; i < 4; ++i) {
                        const int kc = c0 + 16 * half + 4 * g + i;
                        const bool ok = kc >= cs && kc < cs + 16;
                        const float bv = brow[clampi(kc - qc + 15, 0, 30)] * LOG2E;
                        v[half * 4 + i] = ok ? v[half * 4 + i] + bv : -1e30f;
                    }
            }
            float tm = v[0];
#pragma unroll
            for (int i = 1; i < NS * 8; ++i) tm = fmaxf(tm, v[i]);
            tm = fmaxf(tm, __shfl_xor(tm, 16)); tm = fmaxf(tm, __shfl_xor(tm, 32));
            const float mnew = fmaxf(mrun[mp], tm);
            alpha[mp] = ex2(mrun[mp] - mnew);
            mrun[mp] = mnew;
            float ps = 0.f;
#pragma unroll
            for (int sub = 0; sub < NS; ++sub) {
                f32x4 p0, p1;
#pragma unroll
                for (int i = 0; i < 4; ++i) { p0[i] = ex2(v[sub * 8 + i] - mnew); p1[i] = ex2(v[sub * 8 + 4 + i] - mnew); ps += p0[i] + p1[i]; }
                pb[mp][sub] = pack8(p0, p1);
            }
            lrun[mp] = lrun[mp] * alpha[mp] + ps;
        }
#pragma unroll
        for (int dt = 0; dt < 8; ++dt) {
            f32x4 acc[NMAP];
#pragma unroll
            for (int mp = 0; mp < NMAP; ++mp) acc[mp] = o[mp][dt] * alpha[mp];
#pragma unroll
            for (int sub = 0; sub < NS; ++sub) {
                const u32x2 a = *(lds_u2p)(Vt + ((16 * dt + l16) * VROW + kofs + 32 * sub + 4 * g) * 2), b = *(lds_u2p)(Vt + ((16 * dt + l16) * VROW + kofs + 32 * sub + 16 + 4 * g) * 2);
                const u32x4 r = {a[0], a[1], b[0], b[1]};
                const bf16x8 vf = __builtin_bit_cast(bf16x8, r);
#pragma unroll
                for (int mp = 0; mp < NMAP; ++mp) acc[mp] = mfma16(vf, pb[mp][sub], acc[mp]);
            }
#pragma unroll
            for (int mp = 0; mp < NMAP; ++mp) o[mp][dt] = acc[mp];
        }
    };
    gload(0); lstore(); __syncthreads();
    for (int t = 0; t < ntot; ++t) {
        if (t == nt0 && qrow1 != qrow0) {
#pragma unroll
            for (int mp = 0; mp < NMAP; ++mp)
#pragma unroll
                for (int kk = 0; kk < NKK; ++kk) qf[mp][kk] = ld8(qrow1 + (mp * NKK + kk) * 32 + 8 * g);
        }
        if (t + 1 < ntot) gload(t + 1);
        if (NEIGH && t < nt0) {
            const int kr = rsmin + t;
            if (kr >= rs && kr < rs + 8) step(IC<1>{}, c0, true, kr);
        } else {
            step(IC<2>{}, 0, false, 0);
        }
        __syncthreads();
        if (t + 1 < ntot) lstore();
        __syncthreads();
    }
    float inv[NMAP];
#pragma unroll
    for (int mp = 0; mp < NMAP; ++mp) { float lsum = lrun[mp]; lsum += __shfl_xor(lsum, 16); lsum += __shfl_xor(lsum, 32); inv[mp] = 1.0f / lsum; }
    if constexpr (!DIFF) {
#pragma unroll
        for (int dt = 0; dt < 8; ++dt) st4(yrow + 16 * dt + 4 * g, o[0][dt] * inv[0]);
    } else {
        float ss = 0.f;
        f32x4 ov[8];
#pragma unroll
        for (int dt = 0; dt < 8; ++dt) {
            ov[dt] = o[0][dt] * inv[0] - (lam * inv[1]) * o[1][dt];
            ss += ov[dt][0] * ov[dt][0] + ov[dt][1] * ov[dt][1] + ov[dt][2] * ov[dt][2] + ov[dt][3] * ov[dt][3];
        }
        ss += __shfl_xor(ss, 16); ss += __shfl_xor(ss, 32);
        const float rinv = rsqrtf(ss * (1.0f / 128.0f) + 1e-6f) * outscale;
#pragma unroll
        for (int dt = 0; dt < 8; ++dt) st4(yrow + 16 * dt + 4 * g, ov[dt] * rinv * *(const f32x4*)(subln + 16 * dt + 4 * g));
    }
}

constexpr int N_BL = 160, N_AL = 192, N_M3 = 320, N_AC = 192, N_BC = 160, N_MIX = N_BL + N_AL + N_M3 + N_AC + N_BC;
DEVI void mixer_phase(const P& p, int l, PG8_LAS unsigned char* lds) {
    const int tid = TIDX(), lane = tid & 63;
    char* ws = WSP(p.ws);
    unsigned* cnt = (unsigned*)(ws + W_CNT) + 64 * l;
    const float lam_init = l == 0 ? 0.2f : 0.35550906759f;
    float lam;
    {
        const float* bl = p.in[I_LAMBDA] + l * 256;
        const float s1 = wave_sum(bl[lane] * bl[64 + lane]), s2 = wave_sum(bl[128 + lane] * bl[192 + lane]);
        lam = __expf(s1) - __expf(s2) + lam_init;
        lam = __int_as_float(__builtin_amdgcn_readfirstlane(__float_as_int(lam)));
    }
    const bf16_t* Qa = (const bf16_t*)(ws + W_QA); const bf16_t* Ka = (const bf16_t*)(ws + W_KA); const bf16_t* VaT = (const bf16_t*)(ws + W_VAT);
    const bf16_t* Qb = (const bf16_t*)(ws + W_QB); const bf16_t* Qbr = (const bf16_t*)(ws + W_QBR); const bf16_t* Kb = (const bf16_t*)(ws + W_KB); const bf16_t* VbT = (const bf16_t*)(ws + W_VBT);
    bf16_t* Y = (bf16_t*)(ws + W_Y);
    const float scA = 0.08838834764831845f * LOG2E, scB = 0.125f * LOG2E;
    const float* subln = p.in[I_SUBLN] + l * 128;
    PG8_LAS int* s_item = (PG8_LAS int*)(lds + ATT_LDS_BYTES);
#if STATIC_Q
    for (int idx0 = BIDX(); idx0 < N_MIX; idx0 += gridDim.x) {
        int idx = idx0;
#else
    for (;;) {
        if (tid == 0) *s_item = (int)atomicAdd(cnt, 1u);
        __syncthreads();
        int idx = *s_item;
        __syncthreads();
        if (idx >= N_MIX) break;
#endif
        const int tid2 = TIDX(), l16 = tid2 & 15, wv = tid2 >> 6;
#if PROBE
        if (tid == 0 && l == 0) {
            unsigned long long* ts = (unsigned long long*)(p.ws + W_CNT + 2048);
            if (idx == N_BL) ts[42] = wall_clock64();
            if (idx == N_BL + N_AL) ts[43] = wall_clock64();
            if (idx == N_BL + N_AL + N_M3) ts[44] = wall_clock64();
        }
#endif
        if (idx < N_BL) {
            const int b = idx / 80, h = (idx % 80) / 16, qb = idx % 16;
            const int tl = b * 2048 + qb * 128 + wv * 16 + l16, t = TC + tl;
            attn_block<true, false>(lds, Qbr + (size_t)tl * 640 + h * 128, Qb + (size_t)t * 640 + h * 128,
                             Kb + (size_t)(TC + b * 2048) * 640 + h * 128, 640, 0, 32, VbT + LATV_B + (size_t)(b * 5 + h) * 128 * 2048, 2048,
                             (const bf16_t*)(ws + W_CKB) + (size_t)((b * 2 + l) * 5 + h) * 65536, 128, 8, (const bf16_t*)(ws + W_CVB) + (size_t)((b * 2 + l) * 5 + h) * 65536, 512,
                             0, 0, 0, 0, 0, nullptr, scB, Y + (size_t)t * D + 768 + h * 128, lam, subln, 1.0f - lam_init);
            continue;
        }
        idx -= N_BL;
        if (idx < N_AL) {
            const int b = idx / 96, h = (idx % 96) / 16, rp = idx % 16;
            const int r0 = 2 * rp, r = r0 + (wv >> 2), q4 = wv & 3;
            const int qc0 = 16 * q4, c0 = clampi(qc0 - 8, 0, 32), rs = clampi(r - 4, 0, 24), rsmin = clampi(r0 - 4, 0, 24), rsmax = clampi(r0 + 1 - 4, 0, 24);
            const int t = TC + b * 2048 + r * 64 + qc0 + l16;
            const bf16_t* qrow = Qa + (size_t)t * 768 + h * 128;
            attn_block<false, true>(lds, qrow, qrow, Ka + (size_t)(TC + b * 2048) * 768 + h * 128, 768, rsmin * 64, rsmax + 8 - rsmin, VaT + LATV_A + (size_t)(b * 6 + h) * 128 * 2048, 2048,
                              (const bf16_t*)(ws + W_CKA) + (size_t)((b * 2 + l) * 6 + h) * 65536, 128, 8, (const bf16_t*)(ws + W_CVA) + (size_t)((b * 2 + l) * 6 + h) * 65536, 512,
                              r, qc0, c0, rs, rsmin, p.in[I_RPB] + (size_t)(l * 6 + h) * 465, scA, Y + (size_t)t * D + h * 128, 0.f, nullptr, 1.0f);
            continue;
        }
        idx -= N_AL;
        if (idx < N_M3) { m3_item(p, l, idx * 8 + wv); continue; }
        idx -= N_M3;
        if (idx < N_AC) {
            const int b = idx / 12, h = (idx % 12) / 2, qb = idx % 2;
            const int t = b * 256 + qb * 128 + wv * 16 + l16;
            const bf16_t* qrow = Qa + (size_t)t * 768 + h * 128;
            attn_block<false, false>(lds, qrow, qrow, Ka + (size_t)(b * 256) * 768 + h * 128, 768, 0, 4, VaT + (size_t)(b * 6 + h) * 128 * 256, 256,
                              nullptr, 0, 0, nullptr, 0, 0, 0, 0, 0, 0, nullptr, scA, Y + (size_t)t * D + h * 128, 0.f, nullptr, 1.0f);
            continue;
        }
        idx -= N_AC;
        {
            const int b = idx / 10, h = (idx % 10) / 2, qb = idx % 2;
            const int t = b * 256 + qb * 128 + wv * 16 + l16;
            const bf16_t* qrow = Qb + (size_t)t * 640 + h * 128;
            attn_block<true, false>(lds, qrow, qrow, Kb + (size_t)(b * 256) * 640 + h * 128, 640, 0, 4, VbT + (size_t)(b * 5 + h) * 128 * 256, 256,
                             nullptr, 0, 0, nullptr, 0, 0, 0, 0, 0, 0, nullptr, scB, Y + (size_t)t * D + 768 + h * 128, lam, subln, 1.0f - lam_init);
        }
    }
}

#define XB_TMO      128
#define XB_XCNT(j)  (256  + 64 * (j))
#define XB_XSUB(j)  (1280 + 64 * (j))
#define XB_XGEN(j)  (2304 + 64 * (j))
#define XB_TOP      3328
#define XB_TOPGEN   3392
#define XB_SPIN_CAP (1u << 18)
DEVI unsigned xb_ld(unsigned* p) { return __hip_atomic_load(p, __ATOMIC_RELAXED, __HIP_MEMORY_SCOPE_AGENT); }
DEVI unsigned xb_add(unsigned* p, unsigned v) { return __hip_atomic_fetch_add(p, v, __ATOMIC_RELAXED, __HIP_MEMORY_SCOPE_AGENT); }
DEVI unsigned xb_xcc_id() { return (unsigned)__builtin_amdgcn_s_getreg((3 << 11) | 20) & 0xFu; }
#define XB_SPIN(cond, bar) do { unsigned _sp = 0; while (cond) { __builtin_amdgcn_s_sleep(1); \
    if ((++_sp & 255u) == 0u) { if (xb_ld(&(bar)[XB_TMO])) break; if (_sp > XB_SPIN_CAP) { atomicAdd(&(bar)[XB_TMO], 1u); break; } } } } while (0)
struct XcdBarrier { unsigned* bar; unsigned x; volatile PG8_LAS unsigned* st; };
DEVI void xcd_barrier_complete(unsigned* bar, unsigned x, unsigned& nloc, unsigned& nx) {
    const unsigned G = gridDim.x;
    unsigned sum, cnt, mine, sp = 0u;
    for (;;) {
        sum = 0u; cnt = 0u; mine = 0u;
#pragma unroll
        for (unsigned j = 0; j < 16; ++j) { const unsigned c = xb_ld(&bar[XB_XCNT(j)]); sum += c; cnt += (c > 0u) ? 1u : 0u; mine = (j == x) ? c : mine; }
        if (sum == G) break;
        __builtin_amdgcn_s_sleep(1);
        if ((++sp & 255u) == 0u) { if (xb_ld(&bar[XB_TMO])) break; if (sp > XB_SPIN_CAP) { atomicAdd(&bar[XB_TMO], 1u); break; } }
    }
    nloc = mine > 0u ? mine : 1u; nx = cnt > 0u ? cnt : 1u;
}
DEVI void xcd_barrier(const XcdBarrier& b) {
    asm volatile("s_waitcnt vmcnt(0) lgkmcnt(0)" ::: "memory");
    __syncthreads();
    if (threadIdx.x == 0) {
        unsigned* bar = b.bar;
        __builtin_amdgcn_s_waitcnt(0);
        unsigned nloc = b.st[0], nx = b.st[1];
        if (nloc == 0u) { xcd_barrier_complete(bar, b.x, nloc, nx); b.st[0] = nloc; b.st[1] = nx; }
        const unsigned old = xb_add(&bar[XB_XSUB(b.x)], 1u);
        const unsigned gen = old / nloc;
        if (old + 1u == (gen + 1u) * nloc) {
            __builtin_amdgcn_fence(__ATOMIC_RELEASE, "agent");
            asm volatile("s_waitcnt vmcnt(0)" ::: "memory");
            const unsigned og = xb_add(&bar[XB_TOP], 1u);
            const unsigned tg = og / nx;
            if (og + 1u == (tg + 1u) * nx) xb_add(&bar[XB_TOPGEN], 1u);
            else XB_SPIN(xb_ld(&bar[XB_TOPGEN]) == tg, bar);
            __builtin_amdgcn_fence(__ATOMIC_ACQUIRE, "agent");
            xb_add(&bar[XB_XGEN(b.x)], 1u);
            asm volatile("s_waitcnt vmcnt(0)" ::: "memory");
        } else {
            XB_SPIN(xb_ld(&bar[XB_XGEN(b.x)]) == gen, bar);
            __builtin_amdgcn_fence(__ATOMIC_ACQUIRE, "agent");
            asm volatile("s_waitcnt vmcnt(0)" ::: "memory");
        }
    }
    __syncthreads();
}
#define gsync(G) xcd_barrier(xb)
constexpr int NPHASE = 19;
#ifndef PH_END
#define PH_END NPHASE
#endif
DEVI int kind_of_phase(int ph) {
    if (ph < 3) return ph;
    const int k = (ph - 3) % 8;
    return k == 0 ? 3 : k == 1 ? 4 : k == 2 ? 5 : k == 3 ? 6 : (k == 4 || k == 7) ? 7 : k == 5 ? 9 : 10;
}
template <unsigned MASK>
__global__ __launch_bounds__(512, 2) void fwd_kernel(P p) {
    extern __shared__ __attribute__((aligned(16))) unsigned char shm[];
    cg::grid_group grid = cg::this_grid();
    PG8_LAS unsigned char* lds = (PG8_LAS unsigned char*)shm;
    if (p.ph_lo < 0) grid.sync();
    volatile PG8_LAS unsigned* xst = (volatile PG8_LAS unsigned*)(lds + 131072);
    if (threadIdx.x == 0) { xst[0] = 0u; xst[1] = 0u; }
    __syncthreads();
    XcdBarrier xb; xb.bar = (unsigned*)(p.ws + W_BAR); xb.x = xb_xcc_id(); xb.st = xst;
    if (threadIdx.x == 0) (void)xb_add(&xb.bar[XB_XCNT(xb.x)], 1u);
#if PROBE
    unsigned long long* ts = (unsigned long long*)(p.ws + W_CNT + 2048);
    if (blockIdx.x == 0 && threadIdx.x == 0) ts[40] = wall_clock64();
    gsync(grid);
    if (blockIdx.x == 0 && threadIdx.x == 0) ts[41] = wall_clock64();
    gsync(grid);
    if (blockIdx.x == 0 && threadIdx.x == 0) ts[0] = wall_clock64();
#endif
    for (int ph = p.ph_lo; ph < p.ph_hi; ++ph) {
        char* ws = WSP(p.ws);
        const int kind = kind_of_phase(ph);
        const int l = ph < 3 ? 0 : (ph - 3) / 8, k = ph < 3 ? 0 : (ph - 3) % 8;
        const float* mods = (const float*)(ws + W_MODS) + (size_t)l * 36864;
        pg8::StaticOrder S;
        if constexpr ((MASK >> 0) & 1) if (kind == 0) phase0a(p, (float*)shm);
        if constexpr ((MASK >> 1) & 1) if (kind == 1) phase0b(p);
        if constexpr ((MASK >> 2) & 1) if (kind == 2) phase0c(p);
        if constexpr ((MASK >> 3) & 1) if (kind == 3) {
            pg8::Gemm g{(const bf16_t*)(ws + W_H), (const bf16_t*)(ws + W_WIN) + (size_t)l * NINP * D, T, NINP, D};
            S.init(T, NINP, (int)gridDim.x, (int)BIDX());
            EpiIn E{ws, p.out, p.in[I_GATEB], l};
            pg8::gemm_phase<EpiIn, pg8::StaticOrder>(lds, g, S, E);
            if ((int)BIDX() >= 96) weight_units(p, l, 280, 816, (int)BIDX() - 96, (int)gridDim.x - 96, (float*)shm);
        }
        if constexpr ((MASK >> 4) & 1) if (kind == 4) {
            for (int it = BIDX() * 8 + (TIDX() >> 6); it < 1280; it += gridDim.x * 8) m1_item(p, it);
        }
        if constexpr ((MASK >> 5) & 1) if (kind == 5) m2_phase(p, l);
        if constexpr ((MASK >> 6) & 1) if (kind == 6) mixer_phase(p, l, lds);
        if constexpr ((MASK >> 7) & 1) if (kind == 7) {
            float* stats = (float*)(ws + W_MODP);
            unsigned* lncnt = (unsigned*)(ws + W_CNT) + 256;
            const bool last = l == 1;
            if (k == 4) {
                pg8::Gemm g{(const bf16_t*)(ws + W_Y), (const bf16_t*)(ws + W_WOUT) + (size_t)l * D * D, T, D, D};
                S.init(T, D, (int)gridDim.x, (int)BIDX());
                EpiResLN E{l == 0 ? p.in[I_XP] : (const float*)(ws + W_X), l == 0 ? p.in[I_XS] : (const float*)(ws + W_X) + (size_t)TC * XS, (float*)(ws + W_X), mods + 2 * 2048,
                           p.in[I_LN1G] + l * D, p.in[I_LN1B] + l * D, mods + 3 * 2048, (bf16_t*)(ws + W_H), stats + (size_t)(l * 2) * 32 * 256 * 16, lncnt + (l * 2) * 32, l == 0 ? D : XS, XS};
                pg8::gemm_phase<EpiResLN, pg8::StaticOrder>(lds, g, S, E);
            } else {
                pg8::Gemm g{(const bf16_t*)(ws + W_ACT), (const bf16_t*)(ws + W_WDN) + (size_t)l * D * DFF, T, D, DFF};
                S.init(T, D, (int)gridDim.x, (int)BIDX());
                EpiResLN E{(const float*)(ws + W_X), (const float*)(ws + W_X) + (size_t)TC * XS, last ? p.out + O_Y : (float*)(ws + W_X), mods + 5 * 2048,
                           p.in[I_LN2G] + l * D, p.in[I_LN2B] + l * D, last ? nullptr : mods + 36864, (bf16_t*)(ws + W_H), stats + (size_t)(l * 2 + 1) * 32 * 256 * 16, lncnt + (l * 2 + 1) * 32, XS, last ? D : XS};
                pg8::gemm_phase<EpiResLN, pg8::StaticOrder>(lds, g, S, E);
            }
        }
        if constexpr ((MASK >> 9) & 1) if (kind == 9) {
            pg8::Gemm g{(const bf16_t*)(ws + W_H), (const bf16_t*)(ws + W_WUP) + (size_t)l * NUP * D, T, NUP, D};
            S.init(T, NUP, (int)gridDim.x, (int)BIDX());
            EpiU E{(bf16_t*)(ws + W_U)};
            pg8::gemm_phase<EpiU, pg8::StaticOrder>(lds, g, S, E);
            if (l == 0 && (int)BIDX() >= 96) weight_units(p, 1, 0, 280, (int)BIDX() - 96, (int)gridDim.x - 96, (float*)shm);
        }
        if constexpr ((MASK >> 10) & 1) if (kind == 10) conv_phase(p, l);
#if PROBE
        gsync(grid);
        if (blockIdx.x == 0 && threadIdx.x == 0) ts[ph + 1] = wall_clock64();
#else
        if (ph + 1 < p.ph_hi) gsync(grid);
#endif
    }
#if CMP
    gsync(grid);
    if (blockIdx.x == 0) {
        const unsigned* cw = (const unsigned*)(p.ws + W_CNT);
        const size_t offs[8] = {O_Y, O_Y + 8388608, O_AK, O_AV, O_BK, O_BV, O_CC, O_CN};
        for (int c = 0; c < 8; ++c) {
            const unsigned m = __hip_atomic_load(cw + 128 + c, __ATOMIC_RELAXED, __HIP_MEMORY_SCOPE_AGENT);
            const int n = m == 0 ? 0 : (m < 1000 ? 10 : (m < 20000 ? 100 : 1000));
            unsigned* o = (unsigned*)p.out + offs[c];
            for (int i = threadIdx.x; i < n; i += 512) o[i] = 0xAAAAAAAAu;
        }
    }
#endif
#if PROBE
    if (blockIdx.x == 0) {
        __syncthreads();
        const size_t offs[9] = {O_Y, O_Y + 8388608, O_AK, O_AV, O_BK, O_BV, O_CC, O_CN, O_CM};
#if PROBE == 1
        const int ta[9] = {0, 3, 4, 6, 7, 8, 9, 0, 0}, tb[9] = {3, 4, 6, 7, 8, 9, 10, 0, 0};
        const int dv[9] = {400, 400, 400, 400, 400, 400, 400, 100, 100};
#elif PROBE == 4
        const int ta[9] = {3, 4, 6, 7, 8, 9, 10, 0, 0}, tb[9] = {4, 6, 7, 8, 9, 10, 11, 0, 0};
        const int dv[9] = {400, 400, 400, 400, 400, 400, 400, 100, 100};
#elif PROBE == 5
        const int ta[9] = {0, 45, 1, 2, 4, 5, 9, 0, 0}, tb[9] = {45, 1, 2, 3, 5, 6, 10, 0, 0};
        const int dv[9] = {400, 400, 400, 400, 400, 400, 400, 100, 100};
#elif PROBE == 3
        const int ta[9] = {10, 11, 12, 0, 1, 2, 5, 0, 0}, tb[9] = {11, 12, 13, 1, 2, 3, 6, 0, 0};
        const int dv[9] = {400, 400, 400, 400, 400, 400, 400, 100, 100};
#else
        const int ta[9] = {40, 0, 4, 5, 6, 6, 6, 0, 0}, tb[9] = {41, 1, 5, 6, 42, 43, 44, 0, 0};
        const int dv[9] = {40, 400, 400, 400, 400, 400, 400, 100, 100};
#endif
        for (int c = 0; c < 9; ++c) {
            long long d = (long long)(ts[tb[c]] - ts[ta[c]]) / dv[c];
            int n = (int)d; if (c == 8 && n > 320) n = 320; if (c == 7 && n > 40960) n = 40960;
            unsigned* o = (unsigned*)p.out + offs[c];
            for (int i = threadIdx.x; i < n; i += 512) o[i] = 0xAAAAAAAAu;
        }
    }
#endif
}

static int host_kind_of_phase(int ph) {
    if (ph < 3) return ph;
    const int k = (ph - 3) % 8;
    return k == 0 ? 3 : k == 1 ? 4 : k == 2 ? 5 : k == 3 ? 6 : (k == 4 || k == 7) ? 7 : k == 5 ? 9 : 10;
}
typedef void (*kern_t)(P);
extern "C" void kernel_launch(void* const* d_in, const int* in_sizes, int n_in, void* d_out, int out_size, void* d_ws, size_t ws_size, hipStream_t stream) {
    constexpr size_t kDynLds = 131072 + 16;
    static int grid_blocks = 0;
#if ONE_LAUNCH
    static kern_t kerns[1] = {fwd_kernel<0x7ffu>};
    constexpr int NK = 1;
#else
    static kern_t kerns[11] = {fwd_kernel<1u>, fwd_kernel<2u>, fwd_kernel<4u>, fwd_kernel<8u>, fwd_kernel<16u>, fwd_kernel<32u>, fwd_kernel<64u>, fwd_kernel<128u>, fwd_kernel<256u>, fwd_kernel<512u>, fwd_kernel<1024u>};
    constexpr int NK = 11;
#endif
    if (!grid_blocks) {
        int dev = 0, cus = 0, per_cu = 8;
        (void)hipGetDevice(&dev);
        (void)hipDeviceGetAttribute(&cus, hipDeviceAttributeMultiprocessorCount, dev);
        for (int i = 0; i < NK; ++i) {
            int pc = 0;
            (void)hipFuncSetAttribute((const void*)kerns[i], hipFuncAttributeMaxDynamicSharedMemorySize, (int)kDynLds);
            (void)hipOccupancyMaxActiveBlocksPerMultiprocessor(&pc, kerns[i], 512, kDynLds);
            if (pc < per_cu) per_cu = pc;
        }
        if (per_cu < 1) per_cu = 1;
        grid_blocks = cus * per_cu;
        if (ws_size < W_END) fprintf(stderr, "workspace too small: %zu < %zu\n", ws_size, (size_t)W_END);
    }
    P p{};
    for (int i = 0; i < 28; ++i) p.in[i] = (const float*)d_in[i];
    p.out = (float*)d_out;
    p.ws = (char*)d_ws;
    (void)hipMemsetAsync((char*)d_ws + W_CNT, 0, 32768, stream);
#if ONE_LAUNCH
    p.ph_lo = 0; p.ph_hi = NPHASE;
    void* args[] = {&p};
    hipError_t e = hipLaunchCooperativeKernel((const void*)kerns[0], dim3(grid_blocks), dim3(512), args, kDynLds, stream);
    if (e != hipSuccess) fprintf(stderr, "cooperative launch failed: %s (grid %d)\n", hipGetErrorString(e), grid_blocks);
#else
    for (int ph = 0; ph < PH_END; ++ph) {
        p.ph_lo = ph; p.ph_hi = ph + 1;
        hipLaunchKernelGGL(kerns[host_kind_of_phase(ph)], dim3(grid_blocks), dim3(512), kDynLds, stream, p);
    }
#endif
}
```
